# Optimizing an MI355X kernel written in HIP

```python
import math
import numpy as np
import jax
import jax.numpy as jnp
from jax import lax

D_MODEL = 2048
BATCH = 8
SEQ = 2048
DEPTH = 2

D_MIX = D_MODEL
N_MIXERS = 4
W_GROUP = D_MIX // N_MIXERS

ROPE_THETA = 500000.0
Q_BLOCK = 128
NEG_INF = -1.0e30
FORCE_SCORE = 1.0e4

MLA_HEADS = 4
MLA_QK = 128
ROPE_DIM = MLA_QK // 4
MLA_ROPE = ROPE_DIM
MLA_NOPE = MLA_QK - MLA_ROPE
MLA_V = W_GROUP // MLA_HEADS
MLA_Q_LORA = 448
MLA_KV_LORA = 128

NSA_HEADS = 4
NSA_KV_GROUPS = 1
NSA_HPG = NSA_HEADS // NSA_KV_GROUPS
NSA_HD = W_GROUP // NSA_HEADS
CMP_BLOCK = 32
CMP_STRIDE = 16
SEL_BLOCK = 64
N_SEL = 8
N_LOCAL = 2
WINDOW = 512

POOL_SIZES = (2, 4, 8, 16)
POOL_GROUPS = len(POOL_SIZES)
POOL_CH = W_GROUP // POOL_GROUPS

S5_CH = 16
S5_GROUPS = W_GROUP // S5_CH
S5_STATE = 64

MOE_GROUPS = 4
MOE_EPG = 8
MOE_EXPERTS = MOE_GROUPS * MOE_EPG
MOE_TOPK = 2
MOE_HIDDEN = 512

COLS_A = MLA_Q_LORA + MLA_KV_LORA + MLA_ROPE
COLS_B = NSA_HEADS * NSA_HD + 6 * NSA_KV_GROUPS * NSA_HD + 3 * NSA_HEADS
COLS_C = W_GROUP
COLS_D = W_GROUP
N_IN = COLS_A + COLS_B + COLS_C + COLS_D

kernel_name = 'hybrid_mla_nsa_pool_s5_hmoe'


def rmsnorm(x, g, eps=1e-6):
    xf = x.astype(jnp.float32)
    y = xf * lax.rsqrt(jnp.mean(xf * xf, axis=-1, keepdims=True) + eps)
    return (y * g.astype(jnp.float32)).astype(x.dtype)


def rope_tables(seq):
    inv = ROPE_THETA ** (-jnp.arange(0, ROPE_DIM, 2, dtype=jnp.float32) / ROPE_DIM)
    ang = jnp.arange(seq, dtype=jnp.float32)[:, None] * inv[None, :]
    return jnp.cos(ang), jnp.sin(ang)


def apply_rope(x, cos, sin):
    half = cos.shape[-1]
    c = cos[None, :, None, :]
    s = sin[None, :, None, :]
    xf = x.astype(jnp.float32)
    x1, x2, rest = xf[..., :half], xf[..., half:2 * half], xf[..., 2 * half:]
    return jnp.concatenate([x1 * c - x2 * s, x2 * c + x1 * s, rest], axis=-1).astype(x.dtype)


def causal_block_attention(q, k, v):
    B, S, H, Dk = q.shape
    nb = S // Q_BLOCK
    scale = 1.0 / math.sqrt(Dk)
    k_pos = jnp.arange(S)
    qb = q.reshape(B, nb, Q_BLOCK, H, Dk).transpose(1, 0, 2, 3, 4)

    def one_block(args):
        q_blk, blk = args
        q_pos = blk * Q_BLOCK + jnp.arange(Q_BLOCK)
        s = jnp.einsum('bqhd,bkhd->bhqk', q_blk, k, preferred_element_type=jnp.float32) * scale
        s = jnp.where(k_pos[None, :] <= q_pos[:, None], s, NEG_INF)
        p = jax.nn.softmax(s, axis=-1)
        return jnp.einsum('bhqk,bkhd->bqhd', p.astype(v.dtype), v)

    o = lax.map(one_block, (qb, jnp.arange(nb)))
    return o.transpose(1, 0, 2, 3, 4).reshape(B, S, H, v.shape[-1])


def mla_mixer(cols, q_norm_g, kv_norm_g, w_uq, w_ukv, cos, sin):
    B, S, _ = cols.shape
    c_q, c_kv, k_rope = jnp.split(cols, [MLA_Q_LORA, MLA_Q_LORA + MLA_KV_LORA], axis=-1)
    q = (rmsnorm(c_q, q_norm_g) @ w_uq).reshape(B, S, MLA_HEADS, MLA_QK)
    kv = (rmsnorm(c_kv, kv_norm_g) @ w_ukv).reshape(B, S, MLA_HEADS, MLA_NOPE + MLA_V)
    k_nope, v = kv[..., :MLA_NOPE], kv[..., MLA_NOPE:]
    q = jnp.concatenate([q[..., :MLA_NOPE], apply_rope(q[..., MLA_NOPE:], cos, sin)], axis=-1)
    k_rope = apply_rope(k_rope[:, :, None, :], cos, sin)
    k = jnp.concatenate([k_nope, jnp.broadcast_to(k_rope, (B, S, MLA_HEADS, MLA_ROPE))], axis=-1)
    o = causal_block_attention(q, k, v)
    return o.reshape(B, S, MLA_HEADS * MLA_V)


def nsa_compressed(q, kc, vc, cmp_pe, cmp_w1, cmp_w2, scale):
    B, S, G, J, Dh = q.shape
    n_cmp = (S - CMP_BLOCK) // CMP_STRIDE + 1
    idx = np.arange(n_cmp)[:, None] * CMP_STRIDE + np.arange(CMP_BLOCK)[None, :]

    def compress(t, pe, w1, w2):
        blk = t[:, idx] + pe[None, None, :, None, :]
        blk = blk.transpose(0, 1, 3, 2, 4).reshape(B, n_cmp, G, CMP_BLOCK * Dh)
        return jax.nn.gelu(blk @ w1) @ w2

    k_cmp = compress(kc, cmp_pe[0], cmp_w1[0], cmp_w2[0])
    v_cmp = compress(vc, cmp_pe[1], cmp_w1[1], cmp_w2[1])
    s = jnp.einsum('bsgjd,bngd->bgjsn', q, k_cmp, preferred_element_type=jnp.float32) * scale
    blk_end = np.arange(n_cmp) * CMP_STRIDE + CMP_BLOCK - 1
    valid = blk_end[None, :] <= np.arange(S)[:, None]
    s = jnp.where(valid, s, NEG_INF)
    p = jnp.where(valid, jax.nn.softmax(s, axis=-1), 0.0)
    o = jnp.einsum('bgjsn,bngd->bsgjd', p.astype(v_cmp.dtype), v_cmp)
    return o, p


def nsa_select_blocks(p_cmp, S):
    n_cmp = p_cmp.shape[-1]
    n_blk = S // SEL_BLOCK
    c_start = np.arange(n_cmp) * CMP_STRIDE
    b_start = np.arange(n_blk) * SEL_BLOCK
    overlap = ((c_start[:, None] < b_start[None, :] + SEL_BLOCK)
               & (c_start[:, None] + CMP_BLOCK > b_start[None, :])).astype(np.float32)
    imp = jnp.einsum('bgjsn,nk->bgsk', p_cmp, jnp.asarray(overlap))
    cur = (np.arange(S) // SEL_BLOCK)[:, None]
    blk = np.arange(n_blk)[None, :]
    forced = (blk == 0) | ((blk <= cur) & (blk > cur - N_LOCAL))
    valid = blk <= cur
    score = jnp.where(forced, FORCE_SCORE, jnp.where(valid, imp, -1.0))
    _, idx = lax.top_k(score, min(N_SEL, n_blk))
    return idx


def nsa_selected(q, ks, vs, sel_idx, scale):
    B, S, G, J, Dh = q.shape
    nb = S // Q_BLOCK
    n_blk = S // SEL_BLOCK
    n_pick = sel_idx.shape[-1]
    kb = ks.reshape(B, n_blk, SEL_BLOCK, G, Dh).transpose(0, 3, 1, 2, 4)
    vb = vs.reshape(B, n_blk, SEL_BLOCK, G, Dh).transpose(0, 3, 1, 2, 4)
    qb = q.reshape(B, nb, Q_BLOCK, G, J, Dh).transpose(1, 0, 2, 3, 4, 5)
    ib = sel_idx.reshape(B, G, nb, Q_BLOCK, n_pick).transpose(2, 0, 1, 3, 4)
    bi = jnp.arange(B)[:, None, None, None]
    gi = jnp.arange(G)[None, :, None, None]
    tok = jnp.arange(SEL_BLOCK)

    def one_block(args):
        q_blk, i_blk, blk = args
        q_pos = blk * Q_BLOCK + jnp.arange(Q_BLOCK)
        k_sel = kb[bi, gi, i_blk]
        v_sel = vb[bi, gi, i_blk]
        s = jnp.einsum('bqgjd,bgqnld->bgjqnl', q_blk, k_sel, preferred_element_type=jnp.float32) * scale
        k_pos = i_blk[..., None] * SEL_BLOCK + tok
        mask = k_pos <= q_pos[None, None, :, None, None]
        s = jnp.where(mask[:, :, None], s, NEG_INF).reshape(B, G, J, Q_BLOCK, n_pick * SEL_BLOCK)
        p = jax.nn.softmax(s, axis=-1).reshape(B, G, J, Q_BLOCK, n_pick, SEL_BLOCK)
        return jnp.einsum('bgjqnl,bgqnld->bqgjd', p.astype(v_sel.dtype), v_sel)

    o = lax.map(one_block, (qb, ib, jnp.arange(nb)))
    return o.transpose(1, 0, 2, 3, 4, 5).reshape(B, S, G, J, Dh)


def nsa_window(q, kw, vw, scale):
    B, S, G, J, Dh = q.shape
    nb = S // Q_BLOCK
    pad = ((0, 0), (WINDOW, 0), (0, 0), (0, 0))
    kp, vp = jnp.pad(kw, pad), jnp.pad(vw, pad)
    idx = np.arange(nb)[:, None] * Q_BLOCK + np.arange(Q_BLOCK + WINDOW)[None, :]
    k_band, v_band = kp[:, idx], vp[:, idx]
    qb = q.reshape(B, nb, Q_BLOCK, G, J, Dh)
    s = jnp.einsum('bnqgjd,bnkgd->bngjqk', qb, k_band, preferred_element_type=jnp.float32) * scale
    q_pos = np.arange(nb)[:, None] * Q_BLOCK + np.arange(Q_BLOCK)[None, :]
    k_pos = idx - WINDOW
    kq, qq = k_pos[:, None, :], q_pos[:, :, None]
    mask = (kq <= qq) & (kq > qq - WINDOW) & (kq >= 0)
    s = jnp.where(mask[None, :, None, None], s, NEG_INF)
    p = jax.nn.softmax(s, axis=-1)
    o = jnp.einsum('bngjqk,bnkgd->bnqgjd', p.astype(v_band.dtype), v_band)
    return o.reshape(B, S, G, J, Dh)


def nsa_mixer(cols, cmp_pe, cmp_w1, cmp_w2, cos, sin):
    B, S, _ = cols.shape
    G, J, Dh = NSA_KV_GROUPS, NSA_HPG, NSA_HD
    kvw = G * Dh
    splits = [NSA_HEADS * Dh + i * kvw for i in range(7)]
    q, kc, vc, ks, vs, kw, vw, gl = jnp.split(cols, splits, axis=-1)
    q = apply_rope(q.reshape(B, S, NSA_HEADS, Dh), cos, sin).reshape(B, S, G, J, Dh)
    kc, ks, kw = [apply_rope(t.reshape(B, S, G, Dh), cos, sin) for t in (kc, ks, kw)]
    vc, vs, vw = [t.reshape(B, S, G, Dh) for t in (vc, vs, vw)]
    gates = jax.nn.sigmoid(gl.astype(jnp.float32)).reshape(B, S, G, J, 3)
    scale = 1.0 / math.sqrt(Dh)
    o_c, p_cmp = nsa_compressed(q, kc, vc, cmp_pe, cmp_w1, cmp_w2, scale)
    sel_idx = nsa_select_blocks(p_cmp, S)
    o_s = nsa_selected(q, ks, vs, sel_idx, scale)
    o_w = nsa_window(q, kw, vw, scale)
    o = gates[..., 0:1] * o_c + gates[..., 1:2] * o_s + gates[..., 2:3] * o_w
    return o.reshape(B, S, NSA_HEADS * Dh).astype(cols.dtype)


def pool_mixer(u, pool_w, pool_b, pool_scale):
    B, S, _ = u.shape
    uf = u.astype(jnp.float32).reshape(B, S, POOL_GROUPS, POOL_CH)
    cs = jnp.pad(jnp.cumsum(uf, axis=1), ((0, 0), (1, 0), (0, 0), (0, 0)))
    t = np.arange(S)[:, None]
    w = np.array(POOL_SIZES)[None, :]
    lo = np.maximum(t + 1 - w, 0)
    cnt = np.minimum(t + 1, w).astype(np.float32)
    cs_lo = cs[:, lo, np.arange(POOL_GROUPS)[None, :]]
    pooled = (cs[:, 1:] - cs_lo) / cnt[None, :, :, None]
    y = jnp.einsum('bsgc,gcd->bsgd', pooled - uf, pool_w.astype(jnp.float32))
    y = (y.reshape(B, S, W_GROUP) + pool_b.astype(jnp.float32)) * pool_scale.astype(jnp.float32)
    return y.astype(u.dtype)


def s5_combine(e1, e2):
    a1r, a1i, b1r, b1i = e1
    a2r, a2i, b2r, b2i = e2
    return (a2r * a1r - a2i * a1i,
            a2r * a1i + a2i * a1r,
            a2r * b1r - a2i * b1i + b2r,
            a2r * b1i + a2i * b1r + b2i)


def s5_mixer(u, a_re, a_im, log_dt, b_re, b_im, c_re, c_im, d_skip, glu_w, glu_b):
    B, S, _ = u.shape
    uf = u.astype(jnp.float32).reshape(B, S, S5_GROUPS, S5_CH)
    dt = jnp.exp(log_dt.astype(jnp.float32))[:, None]
    lr, li = a_re.astype(jnp.float32), a_im.astype(jnp.float32)
    mag = jnp.exp(lr * dt)
    abar_r, abar_i = mag * jnp.cos(li * dt), mag * jnp.sin(li * dt)
    den = lr * lr + li * li
    nr, ni = abar_r - 1.0, abar_i
    coef_r = (nr * lr + ni * li) / den
    coef_i = (ni * lr - nr * li) / den
    br, bi = b_re.astype(jnp.float32), b_im.astype(jnp.float32)
    bbar_r = coef_r[..., None] * br - coef_i[..., None] * bi
    bbar_i = coef_r[..., None] * bi + coef_i[..., None] * br
    bu_r = jnp.einsum('gpc,bsgc->bsgp', bbar_r, uf)
    bu_i = jnp.einsum('gpc,bsgc->bsgp', bbar_i, uf)
    a_r = jnp.broadcast_to(abar_r, bu_r.shape)
    a_i = jnp.broadcast_to(abar_i, bu_r.shape)
    _, _, x_r, x_i = lax.associative_scan(s5_combine, (a_r, a_i, bu_r, bu_i), axis=1)
    y = (jnp.einsum('gcp,bsgp->bsgc', c_re.astype(jnp.float32), x_r)
         - jnp.einsum('gcp,bsgp->bsgc', c_im.astype(jnp.float32), x_i))
    y = y.reshape(B, S, W_GROUP) + d_skip.astype(jnp.float32) * uf.reshape(B, S, W_GROUP)
    y = jax.nn.gelu(y)
    y = y * jax.nn.sigmoid(y @ glu_w.astype(jnp.float32) + glu_b.astype(jnp.float32))
    return y.astype(u.dtype)


def hmoe(h, w_group, b_group, w_expert, b_expert, w_gate, w_up, w_down):
    B, S, D = h.shape
    t = h.reshape(B * S, D)
    p_group = jax.nn.softmax((t @ w_group).astype(jnp.float32) + b_group.astype(jnp.float32), axis=-1)
    p_top, g_top = lax.top_k(p_group, 1)
    g_onehot = jax.nn.one_hot(g_top[:, 0], MOE_GROUPS, dtype=jnp.float32)
    e_logits = ((t @ w_expert).astype(jnp.float32) + b_expert.astype(jnp.float32)).reshape(-1, MOE_GROUPS, MOE_EPG)
    e_logits = jnp.einsum('tge,tg->te', e_logits, g_onehot)
    p_top2, e_top = lax.top_k(jax.nn.softmax(e_logits, axis=-1), MOE_TOPK)
    p_top2 = p_top2 / jnp.sum(p_top2, axis=-1, keepdims=True)
    w_e = jnp.einsum('tke,tk->te', jax.nn.one_hot(e_top, MOE_EPG, dtype=jnp.float32), p_top2)
    comb = (g_onehot[:, :, None] * (p_top * w_e)[:, None, :]).astype(t.dtype)
    out = jnp.zeros_like(t)
    for g in range(MOE_GROUPS):
        sl = slice(g * MOE_EPG, (g + 1) * MOE_EPG)
        a = jnp.einsum('td,edf->tef', t, w_gate[sl])
        u = jnp.einsum('td,edf->tef', t, w_up[sl])
        hid = jax.nn.silu(a) * u * comb[:, g, :, None]
        out = out + jnp.einsum('tef,efd->td', hid, w_down[sl])
    return out.reshape(B, S, D)


def setup_inputs(seed: int = 0) -> dict:
    key = jax.random.key(seed)
    keys = jax.random.split(key, 40)
    it = iter(range(40))

    def nrm(shape, scale):
        return jax.random.normal(keys[next(it)], shape, jnp.float32) * scale

    def gain(shape):
        return 1.0 + nrm(shape, 0.02)

    L, D = DEPTH, D_MODEL
    x = nrm((BATCH, SEQ, D), 1.0)
    attn_norm_g = gain((L, D))
    w_in = nrm((L, D, N_IN), D ** -0.5)
    mla_q_norm_g = gain((L, MLA_Q_LORA))
    mla_kv_norm_g = gain((L, MLA_KV_LORA))
    mla_w_uq = nrm((L, MLA_Q_LORA, MLA_HEADS * MLA_QK), MLA_Q_LORA ** -0.5)
    mla_w_ukv = nrm((L, MLA_KV_LORA, MLA_HEADS * (MLA_NOPE + MLA_V)), MLA_KV_LORA ** -0.5)
    nsa_cmp_pe = nrm((L, 2, CMP_BLOCK, NSA_HD), 0.1)
    nsa_cmp_w1 = nrm((L, 2, CMP_BLOCK * NSA_HD, NSA_HD), (CMP_BLOCK * NSA_HD) ** -0.5)
    nsa_cmp_w2 = nrm((L, 2, NSA_HD, NSA_HD), NSA_HD ** -0.5)
    pool_w = nrm((L, POOL_GROUPS, POOL_CH, POOL_CH), POOL_CH ** -0.5)
    pool_b = nrm((L, W_GROUP), 0.01)
    pool_scale = gain((L, W_GROUP))
    s5_a_re = -0.5 + nrm((L, S5_GROUPS, S5_STATE), 0.01)
    s5_a_im = jnp.pi * jnp.arange(S5_STATE, dtype=jnp.float32) + nrm((L, S5_GROUPS, S5_STATE), 0.01)
    s5_log_dt = jax.random.uniform(keys[next(it)], (L, S5_GROUPS), jnp.float32,
                                   minval=math.log(1e-3), maxval=math.log(1e-1))
    s5_b_re = nrm((L, S5_GROUPS, S5_STATE, S5_CH), (2 * S5_CH) ** -0.5)
    s5_b_im = nrm((L, S5_GROUPS, S5_STATE, S5_CH), (2 * S5_CH) ** -0.5)
    s5_c_re = nrm((L, S5_GROUPS, S5_CH, S5_STATE), S5_STATE ** -0.5)
    s5_c_im = nrm((L, S5_GROUPS, S5_CH, S5_STATE), S5_STATE ** -0.5)
    s5_d = nrm((L, W_GROUP), 0.5)
    s5_glu_w = nrm((L, W_GROUP, W_GROUP), W_GROUP ** -0.5)
    s5_glu_b = nrm((L, W_GROUP), 0.01)
    mix_norm_g = gain((L, D_MIX))
    w_out = nrm((L, D_MIX, D), D_MIX ** -0.5)
    ffn_norm_g = gain((L, D))
    moe_w_group = nrm((L, D, MOE_GROUPS), D ** -0.5)
    moe_b_group = nrm((L, MOE_GROUPS), 0.01)
    moe_w_expert = nrm((L, D, MOE_EXPERTS), D ** -0.5)
    moe_b_expert = nrm((L, MOE_EXPERTS), 0.01)
    moe_w_gate = nrm((L, MOE_EXPERTS, D, MOE_HIDDEN), D ** -0.5)
    moe_w_up = nrm((L, MOE_EXPERTS, D, MOE_HIDDEN), D ** -0.5)
    moe_w_down = nrm((L, MOE_EXPERTS, MOE_HIDDEN, D), MOE_HIDDEN ** -0.5)
    final_norm_g = gain((D,))
    return {'x': x, 'attn_norm_g': attn_norm_g, 'w_in': w_in,
            'mla_q_norm_g': mla_q_norm_g, 'mla_kv_norm_g': mla_kv_norm_g,
            'mla_w_uq': mla_w_uq, 'mla_w_ukv': mla_w_ukv,
            'nsa_cmp_pe': nsa_cmp_pe, 'nsa_cmp_w1': nsa_cmp_w1, 'nsa_cmp_w2': nsa_cmp_w2,
            'pool_w': pool_w, 'pool_b': pool_b, 'pool_scale': pool_scale,
            's5_a_re': s5_a_re, 's5_a_im': s5_a_im, 's5_log_dt': s5_log_dt,
            's5_b_re': s5_b_re, 's5_b_im': s5_b_im, 's5_c_re': s5_c_re, 's5_c_im': s5_c_im,
            's5_d': s5_d, 's5_glu_w': s5_glu_w, 's5_glu_b': s5_glu_b,
            'mix_norm_g': mix_norm_g, 'w_out': w_out, 'ffn_norm_g': ffn_norm_g,
            'moe_w_group': moe_w_group, 'moe_b_group': moe_b_group,
            'moe_w_expert': moe_w_expert, 'moe_b_expert': moe_b_expert,
            'moe_w_gate': moe_w_gate, 'moe_w_up': moe_w_up, 'moe_w_down': moe_w_down,
            'final_norm_g': final_norm_g}


def reference(x, attn_norm_g, w_in, mla_q_norm_g, mla_kv_norm_g, mla_w_uq, mla_w_ukv,
              nsa_cmp_pe, nsa_cmp_w1, nsa_cmp_w2, pool_w, pool_b, pool_scale,
              s5_a_re, s5_a_im, s5_log_dt, s5_b_re, s5_b_im, s5_c_re, s5_c_im,
              s5_d, s5_glu_w, s5_glu_b, mix_norm_g, w_out, ffn_norm_g,
              moe_w_group, moe_b_group, moe_w_expert, moe_b_expert,
              moe_w_gate, moe_w_up, moe_w_down, final_norm_g):
    B, S, _ = x.shape
    cos, sin = rope_tables(S)
    split_at = [COLS_A, COLS_A + COLS_B, COLS_A + COLS_B + COLS_C]
    for l in range(DEPTH):
        h = rmsnorm(x, attn_norm_g[l])
        c_a, c_b, c_c, c_d = jnp.split(h @ w_in[l], split_at, axis=-1)
        y_a = mla_mixer(c_a, mla_q_norm_g[l], mla_kv_norm_g[l], mla_w_uq[l], mla_w_ukv[l], cos, sin)
        y_b = nsa_mixer(c_b, nsa_cmp_pe[l], nsa_cmp_w1[l], nsa_cmp_w2[l], cos, sin)
        y_c = pool_mixer(c_c, pool_w[l], pool_b[l], pool_scale[l])
        y_d = s5_mixer(c_d, s5_a_re[l], s5_a_im[l], s5_log_dt[l], s5_b_re[l], s5_b_im[l],
                       s5_c_re[l], s5_c_im[l], s5_d[l], s5_glu_w[l], s5_glu_b[l])
        y = jnp.stack([y_a, y_b, y_c, y_d], axis=2)
        y = rmsnorm(y, mix_norm_g[l].reshape(N_MIXERS, W_GROUP)).reshape(B, S, D_MIX)
        x = x + y @ w_out[l]
        x = x + hmoe(rmsnorm(x, ffn_norm_g[l]), moe_w_group[l], moe_b_group[l],
                     moe_w_expert[l], moe_b_expert[l], moe_w_gate[l], moe_w_up[l], moe_w_down[l])
    return rmsnorm(x, final_norm_g)
```

```cpp
#include <hip/hip_runtime.h>
#include <stdint.h>
#include <stdio.h>
#include <string.h>

#ifndef N_LAUNCH_SPLIT
#define N_LAUNCH_SPLIT 0
#endif

#define LAS __attribute__((address_space(3)))
typedef unsigned short bf16_t;
typedef short bf16x8 __attribute__((ext_vector_type(8)));
typedef short s16x4 __attribute__((ext_vector_type(4)));
typedef float f32x4 __attribute__((ext_vector_type(4)));
typedef float f32x16 __attribute__((ext_vector_type(16)));
typedef unsigned u32x4 __attribute__((ext_vector_type(4)));
typedef unsigned u32x2 __attribute__((ext_vector_type(2)));

constexpr int T_ = 16384, S_ = 2048, NB_ = 8, DM = 2048, DEPTH_ = 2;
constexpr int NIN = 2924, NINP = 3072;
constexpr int C_CQ = 0, C_CKV = 448, C_KROPE = 576, C_Q = 608, C_KC = 1120, C_VC = 1248, C_KS = 1376, C_VS = 1504, C_KW = 1632, C_VW = 1760,
              C_CC = 1888, C_CD = 2400, C_GL = 2912;
constexpr int NEXP = 32, MOE_H = 512;
constexpr int MOE_ROWS = 32768 + 32 * 256;
constexpr int S5L = 32, S5ROWS = T_ / S5L;

#define OPQ_IDS int TID_ = threadIdx.x; asm volatile("" : "+v"(TID_)); int BID_ = blockIdx.x; asm volatile("" : "+s"(BID_)); int NBLK_ = gridDim.x; asm volatile("" : "+s"(NBLK_));
__device__ __forceinline__ unsigned cvt_pk_bf16(float lo, float hi) { unsigned r; asm volatile("v_cvt_pk_bf16_f32 %0, %1, %2" : "=v"(r) : "v"(lo), "v"(hi)); return r; }
__device__ __forceinline__ bf16_t f2bf(float f) { return (bf16_t)(cvt_pk_bf16(f, 0.f) & 0xffffu); }
__device__ __forceinline__ float bf2f(bf16_t b) { return __uint_as_float(((unsigned)b) << 16); }
__device__ __forceinline__ float bflo(unsigned w) { return __uint_as_float(w << 16); }
__device__ __forceinline__ float bfhi(unsigned w) { return __uint_as_float(w & 0xffff0000u); }
__device__ __forceinline__ float gelu_tanh(float x) { const float u = 0.7978845608028654f * (x + 0.044715f * x * x * x); const float e = __expf(2.f * u); const float th = 1.f - 2.f / (e + 1.f); return 0.5f * x * (1.f + th); }
__device__ __forceinline__ float sigmoidf_(float x) { return 1.f / (1.f + __expf(-x)); }
__device__ __forceinline__ void sincos_r(float ang, float* s, float* c) { const double rev = (double)ang * 0.15915494309189535; const float fr = (float)(rev - floor(rev)); *s = __builtin_amdgcn_sinf(fr); *c = __builtin_amdgcn_cosf(fr); }
__device__ __forceinline__ float wave_sum(float v) { for (int o = 32; o > 0; o >>= 1) v += __shfl_xor(v, o); return v; }

#define XB_TMO      128
#define XB_XCNT(j)  (256  + 64 * (j))
#define XB_XSUB(j)  (1280 + 64 * (j))
#define XB_XGEN(j)  (2304 + 64 * (j))
#define XB_TOP      3328
#define XB_TOPGEN   3392
#define XCD_BAR_WORDS 3456
#define XB_SPIN_CAP (1u << 22)
__device__ __forceinline__ unsigned xb_ld(unsigned* p)              { return __hip_atomic_load(p, __ATOMIC_RELAXED, __HIP_MEMORY_SCOPE_AGENT); }
__device__ __forceinline__ unsigned xb_add(unsigned* p, unsigned v) { return __hip_atomic_fetch_add(p, v, __ATOMIC_RELAXED, __HIP_MEMORY_SCOPE_AGENT); }
__device__ __forceinline__ unsigned xb_xcc_id() { return (unsigned)__builtin_amdgcn_s_getreg((3 << 11) | 20) & 0xFu; }
#define XB_SPIN(cond, bar) do { unsigned _sp = 0; while (cond) { __builtin_amdgcn_s_sleep(1); \
    if ((++_sp & 255u) == 0u) { if (xb_ld(&(bar)[XB_TMO])) break; if (_sp > XB_SPIN_CAP) { atomicAdd(&(bar)[XB_TMO], 1u); break; } } } } while (0)
struct XcdBarrier { unsigned* bar; unsigned x; volatile LAS unsigned* st; };
__device__ __forceinline__ XcdBarrier xcd_barrier_post(unsigned* bar, volatile LAS unsigned* st) {
    XcdBarrier b; b.bar = bar; b.x = xb_xcc_id(); b.st = st;
    if (threadIdx.x == 0) (void)xb_add(&bar[XB_XCNT(b.x)], 1u);
    return b;
}
__device__ __forceinline__ void xcd_barrier_complete(unsigned* bar, unsigned x, unsigned& nloc, unsigned& nx) {
    const unsigned G = gridDim.x * gridDim.y * gridDim.z;
    unsigned sum, cnt, mine, sp = 0u;
    for (;;) {
        sum = 0u; cnt = 0u; mine = 0u;
#pragma unroll
        for (unsigned j = 0; j < 16; ++j) { const unsigned c = xb_ld(&bar[XB_XCNT(j)]); sum += c; cnt += (c > 0u) ? 1u : 0u; mine = (j == x) ? c : mine; }
        if (sum == G) break;
        __builtin_amdgcn_s_sleep(1);
        if ((++sp & 255u) == 0u) { if (xb_ld(&bar[XB_TMO])) break; if (sp > XB_SPIN_CAP) { atomicAdd(&bar[XB_TMO], 1u); break; } }
    }
    nloc = mine > 0u ? mine : 1u; nx = cnt > 0u ? cnt : 1u;
}
__device__ __forceinline__ void xcd_barrier_census(const XcdBarrier& b) {
    if (threadIdx.x == 0) { unsigned nloc, nx; xcd_barrier_complete(b.bar, b.x, nloc, nx); b.st[0] = nloc; b.st[1] = nx; }
    __syncthreads();
}
__device__ __forceinline__ void xcd_barrier(const XcdBarrier& b) {
    asm volatile("s_waitcnt vmcnt(0)" ::: "memory");
    __syncthreads();
    if (threadIdx.x == 0) {
        unsigned* bar = b.bar;
        __builtin_amdgcn_s_waitcnt(0);
        const unsigned nloc = b.st[0], nx = b.st[1];
        const unsigned old = xb_add(&bar[XB_XSUB(b.x)], 1u);
        const unsigned gen = old / nloc;
        if (old + 1u == (gen + 1u) * nloc) {
            __builtin_amdgcn_fence(__ATOMIC_RELEASE, "agent");
            asm volatile("s_waitcnt vmcnt(0)" ::: "memory");
            const unsigned og = xb_add(&bar[XB_TOP], 1u);
            const unsigned tg = og / nx;
            if (og + 1u == (tg + 1u) * nx) xb_add(&bar[XB_TOPGEN], 1u);
            else XB_SPIN(xb_ld(&bar[XB_TOPGEN]) == tg, bar);
            __builtin_amdgcn_fence(__ATOMIC_ACQUIRE, "agent");
            xb_add(&bar[XB_XGEN(b.x)], 1u);
            asm volatile("s_waitcnt vmcnt(0)" ::: "memory");
        } else {
            XB_SPIN(xb_ld(&bar[XB_XGEN(b.x)]) == gen, bar);
            __builtin_amdgcn_fence(__ATOMIC_ACQUIRE, "agent");
            asm volatile("s_waitcnt vmcnt(0)" ::: "memory");
        }
    }
    __syncthreads();
}

constexpr size_t al256(size_t x) { return (x + 255) & ~(size_t)255; }
struct WsMap {
    size_t ctl, win, wuq, wukv, wcmp1, wpool, wglu, wout, wrt, wgu, wdn, s5t, s5w, s5v, s5pow, cmpb1, rope,
           h, cols, cqn, ckvn, krope, pd, ud, kcc, vcc, mq, mkv, zk, zv, kcmp, vcmp, yintra, xend, xprev, yg, ycat, oc, os, ow,
           logits, mlist, mwt, mtok, hmid, yd, end;
};
constexpr size_t CTL_BYTES = 65536;
constexpr int CW_BAR = 0;
constexpr int CW_CNT = 4096;
constexpr int CW_QUEUE = 4096 + 256;
constexpr int CW_DBG = 8192;
constexpr WsMap make_ws() {
    WsMap w{}; size_t o = 0;
    w.ctl = o; o += CTL_BYTES;
    w.win = o;   o += al256((size_t)NINP * DM * 2);
    w.wuq = o;   o += al256((size_t)512 * 512 * 2);
    w.wukv = o;  o += al256((size_t)1024 * 256 * 2);
    w.wcmp1 = o; o += al256((size_t)2 * 256 * 2048 * 2);
    w.wpool = o; o += al256((size_t)512 * 512 * 2);
    w.wglu = o;  o += al256((size_t)512 * 512 * 2);
    w.wout = o;  o += al256((size_t)DM * DM * 2);
    w.wrt = o;   o += al256((size_t)256 * DM * 2);
    w.wgu = o;   o += al256((size_t)NEXP * 1024 * DM * 2);
    w.wdn = o;   o += al256((size_t)NEXP * DM * MOE_H * 2);
    w.s5t = o;   o += al256((size_t)32 * 512 * 512 * 2);
    w.s5w = o;   o += al256((size_t)32 * 256 * 512 * 2);
    w.s5v = o;   o += al256((size_t)32 * 512 * 256 * 2);
    w.s5pow = o; o += al256((size_t)32 * 32 * 256 * 4);
    w.cmpb1 = o; o += al256((size_t)2 * 128 * 4);
    w.rope = o;  o += al256((size_t)S_ * 32 * 4);
    w.h = o;     o += al256((size_t)T_ * DM * 2);
    w.cols = o;  o += al256((size_t)T_ * NINP * 2);
    w.cqn = o;   o += al256((size_t)T_ * 512 * 2);
    w.ckvn = o;  o += al256((size_t)T_ * 256 * 2);
    w.krope = o; o += al256((size_t)T_ * 32 * 2);
    w.pd = o;    o += al256((size_t)T_ * 512 * 2);
    w.ud = o;    o += al256((size_t)T_ * 512 * 2);
    w.kcc = o;   o += al256((size_t)T_ * 128 * 2);
    w.vcc = o;   o += al256((size_t)T_ * 128 * 2);
    w.mq = o;    o += al256((size_t)T_ * 512 * 2);
    w.mkv = o;   o += al256((size_t)T_ * 1024 * 2);
    w.zk = o;    o += al256((size_t)1024 * 256 * 4);
    w.zv = o;    o += al256((size_t)1024 * 256 * 4);
    w.kcmp = o;  o += al256((size_t)NB_ * 128 * 128 * 2);
    w.vcmp = o;  o += al256((size_t)NB_ * 128 * 128 * 2);
    w.yintra = o; o += al256((size_t)T_ * 512 * 2);
    w.xend = o;  o += al256((size_t)32 * S5ROWS * 128 * 4);
    w.xprev = o; o += al256((size_t)32 * S5ROWS * 256 * 2);
    w.yg = o;    o += al256((size_t)T_ * 512 * 2);
    w.ycat = o;  o += al256((size_t)T_ * DM * 2);
    w.oc = o;    o += al256((size_t)T_ * 512 * 2);
    w.os = o;    o += al256((size_t)T_ * 512 * 2);
    w.ow = o;    o += al256((size_t)T_ * 512 * 2);
    w.logits = o; o += al256((size_t)T_ * 256 * 4);
    w.mlist = o; o += al256((size_t)NEXP * T_ * 4);
    w.mwt = o;   o += al256((size_t)NEXP * T_ * 4);
    w.mtok = o;  o += al256((size_t)T_ * 4 * 4);
    w.hmid = o;  o += al256((size_t)MOE_ROWS * MOE_H * 2);
    w.yd = o;    o += al256((size_t)MOE_ROWS * DM * 2);
    w.end = o;
    return w;
}
constexpr WsMap WS = make_ws();
constexpr size_t WS_XG = WS.cols;
static_assert(WS.zk - WS.cols >= (size_t)MOE_ROWS * DM * 2, "Xg alias");

struct Params {
    const float* in[34];
    float* out;
    unsigned char* ws;
    int ph_lo, ph_hi;
};

namespace g8 {
constexpr int BM = 256, BK = 64, HALF = 128, HTB = HALF * BK * 2, STAGE_BYTES = 8 * HTB, NXCD = 8, WGM = 8;
__host__ __device__ __forceinline__ int lds_byte(int r, int c) { const int st = (r >> 4) * 2 + (c >> 5), rr = r & 15, cc = c & 31, ob = rr * 64 + cc * 2; return st * 1024 + (ob ^ (((ob >> 9) & 1) << 5)); }
__host__ __device__ __forceinline__ void stage_rc(int b, int& R, int& C) { const int st = b / 1024, sb = b % 1024, swz = sb ^ (((sb >> 9) & 1) << 5); R = (st >> 1) * 16 + swz / 64; C = (st & 1) * 32 + (swz % 64) / 2; }
__host__ __device__ __forceinline__ int perm32(int rho) { const int n = rho >> 4, i = rho & 15; return 8 * (i >> 2) + 4 * n + (i & 3); }

enum { E_BF16 = 0, E_F32 = 1, E_POOL = 2, E_GLU = 3, E_S5OUT = 4, E_RESID = 5, E_SWIGLU = 6, E_DOWN = 7 };

struct GDesc {
    const bf16_t* A; const bf16_t* B;
    long long a_gs, b_gs;
    int lda, ldb, K;
    int nM, nN, nG;
    int epi, perm;
    void* C; long long c_gs; int ldc, coff, nvalid;
    const float* v0; const float* v1;
    const bf16_t* aux; long long aux_gs; int aux_ld;
    const float* X;
    int moe;
};
struct MoeCtx { const LAS int* cnt; const int* mlist; const float* mwt; };
__device__ __forceinline__ int rfl(int v) { return __builtin_amdgcn_readfirstlane(v); }
template <class P> __device__ __forceinline__ P* rflp(P* p) { const unsigned long long a = (unsigned long long)p; const unsigned lo = (unsigned)__builtin_amdgcn_readfirstlane((int)(unsigned)a), hi = (unsigned)__builtin_amdgcn_readfirstlane((int)(unsigned)(a >> 32)); return (P*)(((unsigned long long)hi << 32) | lo); }

struct UnitRef {
    const char* A; const char* B; unsigned lda2, ldb2; int nt;
    int d, grp, pm, pn, perm; int rowbase;
};

constexpr int MAXU = 16;
struct URec { unsigned a_lo, a_hi, b_lo, b_hi, lda2, ldb2, nt, g_lo, g_hi, gcnt, d, grp, pm, pn, perm_valid, rowbase; };
struct UnitSrc {
    const LAS GDesc* tab; int d_lo, d_hi; int G, c;
    const LAS int* moe_tiles;
    LAS URec* rec;
    __device__ __forceinline__ int desc_units(int d) const { const LAS GDesc& g = tab[d]; if (g.moe) return moe_tiles[32] * g.nN; return g.nG * g.nM * g.nN; }
    __device__ __forceinline__ void build(const MoeCtx& mc) const {
        const int i = threadIdx.x;
        if (i < MAXU) {
            URec r{}; r.perm_valid = 0;
            long L = (long)i * G + c; int d = d_lo;
            for (; d < d_hi; ++d) { const int n = desc_units(d); if (L < n) break; L -= n; }
            if (d < d_hi) {
                const LAS GDesc& g = tab[d];
                const int moe = g.moe, nN = g.nN, nM = g.nM; const bf16_t* gA = g.A; const bf16_t* gB = g.B; const long long a_gs = g.a_gs, b_gs = g.b_gs;
                const unsigned lda2 = (unsigned)g.lda * 2u, ldb2 = (unsigned)g.ldb * 2u;
                const char* A; const char* B; int rowbase = 0, grp, pm, pn;
                if (moe) {
                    const int tile = (int)(L / nN); pn = (int)(L % nN);
                    int e = 0;
#pragma unroll 1
                    while (e < 31 && tile >= moe_tiles[e + 1]) ++e;
                    const int mt = tile - moe_tiles[e];
                    grp = e; pm = mt; rowbase = tile * 256;
                    B = (const char*)(gB + (size_t)e * b_gs) + (size_t)pn * 256 * ldb2;
                    A = (const char*)gA + (size_t)tile * 256 * lda2;
                } else {
                    const int per = nM * nN; grp = (int)(L / per); int wgid = (int)(L % per);
                    const int nwg = per; { const int q = nwg / NXCD, rr = nwg % NXCD, xcd = wgid % NXCD, off = wgid / NXCD; wgid = (xcd < rr ? xcd * (q + 1) : rr * (q + 1) + (xcd - rr) * q) + off; }
                    const int nig = WGM * nN, gid = wgid / nig, fm = gid * WGM, gsz = (nM - fm) < WGM ? (nM - fm) : WGM;
                    pm = fm + ((wgid % nig) % gsz); pn = (wgid % nig) / gsz;
                    A = (const char*)(gA + (size_t)grp * a_gs) + (size_t)pm * 256 * lda2;
                    B = (const char*)(gB + (size_t)grp * b_gs) + (size_t)pn * 256 * ldb2;
                }
                r.a_lo = (unsigned)(unsigned long long)A; r.a_hi = (unsigned)((unsigned long long)A >> 32); r.b_lo = (unsigned)(unsigned long long)B; r.b_hi = (unsigned)((unsigned long long)B >> 32);
                r.lda2 = lda2; r.ldb2 = ldb2; r.nt = (unsigned)(g.K / BK); r.g_lo = 0; r.g_hi = 0; r.gcnt = 0;
                r.d = (unsigned)d; r.grp = (unsigned)grp; r.pm = (unsigned)pm; r.pn = (unsigned)pn; r.perm_valid = 2u | (unsigned)(g.perm & 1); r.rowbase = (unsigned)rowbase;
            }
            LAS unsigned* dst = (LAS unsigned*)&rec[i];
            dst[0] = r.a_lo; dst[1] = r.a_hi; dst[2] = r.b_lo; dst[3] = r.b_hi; dst[4] = r.lda2; dst[5] = r.ldb2; dst[6] = r.nt; dst[7] = r.g_lo; dst[8] = r.g_hi; dst[9] = r.gcnt;
            dst[10] = r.d; dst[11] = r.grp; dst[12] = r.pm; dst[13] = r.pn; dst[14] = r.perm_valid; dst[15] = r.rowbase;
        }
    }
    __device__ __forceinline__ bool get(int i, UnitRef& u) const {
        if (i >= MAXU) return false;
        const LAS unsigned* s = (const LAS unsigned*)&rec[i];
        const unsigned pv = (unsigned)rfl((int)s[14]);
        if (!(pv & 2u)) return false;
        const unsigned long long a = ((unsigned long long)(unsigned)rfl((int)s[1]) << 32) | (unsigned)rfl((int)s[0]), b = ((unsigned long long)(unsigned)rfl((int)s[3]) << 32) | (unsigned)rfl((int)s[2]);
        u.A = (const char*)a; u.B = (const char*)b; u.lda2 = (unsigned)rfl((int)s[4]); u.ldb2 = (unsigned)rfl((int)s[5]); u.nt = rfl((int)s[6]);
        u.d = rfl((int)s[10]); u.grp = rfl((int)s[11]); u.pm = rfl((int)s[12]); u.pn = rfl((int)s[13]); u.perm = (int)(pv & 1u); u.rowbase = rfl((int)s[15]);
        return true;
    }
};

__device__ __forceinline__ u32x4 pack8(const f32x4& a, const f32x4& b) { u32x4 w; w.x = cvt_pk_bf16(a[0], a[1]); w.y = cvt_pk_bf16(a[2], a[3]); w.z = cvt_pk_bf16(b[0], b[1]); w.w = cvt_pk_bf16(b[2], b[3]); return w; }

__device__ __forceinline__ void epilogue(const f32x4 (&acc)[2][2][4][2], const GDesc g, const UnitRef& u, const MoeCtx& mc, int wr, int wc, int fr, int fq) {
    const int row0 = u.pm * 256 + wr * 64 + fr;
    const int colp = u.pn * 256 + wc * 32 + 8 * fq;
    const int coln = u.pn * 256 + wc * 32 + 4 * fq;
    switch (g.epi) {
    case E_BF16: {
        bf16_t* base = (bf16_t*)g.C + (size_t)u.grp * g.c_gs + g.coff;
#pragma unroll
        for (int ai = 0; ai < 2; ++ai)
#pragma unroll
            for (int m = 0; m < 4; ++m) { bf16_t* rowp = base + (size_t)(row0 + ai * HALF + m * 16) * g.ldc + colp;
#pragma unroll
                for (int bj = 0; bj < 2; ++bj) *(u32x4*)(rowp + bj * HALF) = pack8(acc[ai][bj][m][0], acc[ai][bj][m][1]); }
    } break;
    case E_F32: {
        float* base = (float*)g.C + (size_t)u.grp * g.c_gs + g.coff;
#pragma unroll
        for (int ai = 0; ai < 2; ++ai)
#pragma unroll
            for (int m = 0; m < 4; ++m) { float* rowp = base + (size_t)(row0 + ai * HALF + m * 16) * g.ldc;
#pragma unroll
                for (int bj = 0; bj < 2; ++bj)
#pragma unroll
                    for (int n = 0; n < 2; ++n) { const int c = coln + bj * HALF + n * 16; if (c < g.nvalid) *(f32x4*)(rowp + c) = acc[ai][bj][m][n]; } }
    } break;
    case E_POOL: {
        bf16_t* base = (bf16_t*)g.C + g.coff;
        f32x4 b0[2][2], s0[2][2];
#pragma unroll
        for (int bj = 0; bj < 2; ++bj)
#pragma unroll
            for (int n = 0; n < 2; ++n) { b0[bj][n] = *(const f32x4*)(g.v0 + colp + bj * HALF + 4 * n); s0[bj][n] = *(const f32x4*)(g.v1 + colp + bj * HALF + 4 * n); }
#pragma unroll
        for (int ai = 0; ai < 2; ++ai)
#pragma unroll
            for (int m = 0; m < 4; ++m) { bf16_t* rowp = base + (size_t)(row0 + ai * HALF + m * 16) * g.ldc + colp;
#pragma unroll
                for (int bj = 0; bj < 2; ++bj) { const f32x4 a = (acc[ai][bj][m][0] + b0[bj][0]) * s0[bj][0], b = (acc[ai][bj][m][1] + b0[bj][1]) * s0[bj][1];
                    *(u32x4*)(rowp + bj * HALF) = pack8(a, b); } }
    } break;
    case E_GLU: {
        bf16_t* base = (bf16_t*)g.C + g.coff;
        f32x4 b0[2][2];
#pragma unroll
        for (int bj = 0; bj < 2; ++bj)
#pragma unroll
            for (int n = 0; n < 2; ++n) b0[bj][n] = *(const f32x4*)(g.v0 + colp + bj * HALF + 4 * n);
#pragma unroll
        for (int ai = 0; ai < 2; ++ai)
#pragma unroll
            for (int m = 0; m < 4; ++m) { const size_t r = (size_t)(row0 + ai * HALF + m * 16); bf16_t* rowp = base + r * g.ldc + colp;
#pragma unroll
                for (int bj = 0; bj < 2; ++bj) { const u32x4 y = *(const u32x4*)(g.aux + r * g.aux_ld + colp + bj * HALF);
                    const f32x4 z0 = acc[ai][bj][m][0] + b0[bj][0], z1 = acc[ai][bj][m][1] + b0[bj][1];
                    f32x4 a, b;
                    a[0] = bflo(y.x) * sigmoidf_(z0[0]); a[1] = bfhi(y.x) * sigmoidf_(z0[1]); a[2] = bflo(y.y) * sigmoidf_(z0[2]); a[3] = bfhi(y.y) * sigmoidf_(z0[3]);
                    b[0] = bflo(y.z) * sigmoidf_(z1[0]); b[1] = bfhi(y.z) * sigmoidf_(z1[1]); b[2] = bflo(y.w) * sigmoidf_(z1[2]); b[3] = bfhi(y.w) * sigmoidf_(z1[3]);
                    *(u32x4*)(rowp + bj * HALF) = pack8(a, b); } }
    } break;
    case E_S5OUT: {
        bf16_t* yg = (bf16_t*)g.C; const bf16_t* yin = g.aux + (size_t)u.grp * g.aux_gs;
#pragma unroll
        for (int ai = 0; ai < 2; ++ai)
#pragma unroll
            for (int m = 0; m < 4; ++m) { const size_t r = (size_t)(row0 + ai * HALF + m * 16);
#pragma unroll
                for (int bj = 0; bj < 2; ++bj) { const int c = colp + bj * HALF; const u32x4 y = *(const u32x4*)(yin + r * g.aux_ld + c);
                    const f32x4 z0 = acc[ai][bj][m][0], z1 = acc[ai][bj][m][1];
                    f32x4 a, b;
                    a[0] = gelu_tanh(z0[0] + bflo(y.x)); a[1] = gelu_tanh(z0[1] + bfhi(y.x)); a[2] = gelu_tanh(z0[2] + bflo(y.y)); a[3] = gelu_tanh(z0[3] + bfhi(y.y));
                    b[0] = gelu_tanh(z1[0] + bflo(y.z)); b[1] = gelu_tanh(z1[1] + bfhi(y.z)); b[2] = gelu_tanh(z1[2] + bflo(y.w)); b[3] = gelu_tanh(z1[3] + bfhi(y.w));
                    const int t = c >> 4, ch = c & 15;
                    *(u32x4*)(yg + (r * 32 + t) * 512 + 16 * u.grp + ch) = pack8(a, b); } }
    } break;
    case E_RESID: {
        float* base = (float*)g.C; const float* xin = g.X;
#pragma unroll
        for (int ai = 0; ai < 2; ++ai)
#pragma unroll
            for (int m = 0; m < 4; ++m) { const size_t ro = (size_t)(row0 + ai * HALF + m * 16) * g.ldc;
#pragma unroll
                for (int bj = 0; bj < 2; ++bj)
#pragma unroll
                    for (int n = 0; n < 2; ++n) { const int c = coln + bj * HALF + n * 16; *(f32x4*)(base + ro + c) = *(const f32x4*)(xin + ro + c) + acc[ai][bj][m][n]; } }
    } break;
    case E_SWIGLU: {
        bf16_t* hm = (bf16_t*)g.C; const int e = u.grp; const int cnt = rfl(mc.cnt[e]);
        const int f0 = u.pn * 128 + wc * 16 + 4 * fq;
#pragma unroll
        for (int ai = 0; ai < 2; ++ai)
#pragma unroll
            for (int m = 0; m < 4; ++m) { const int lr = wr * 64 + fr + ai * HALF + m * 16; const int slot = u.pm * 256 + lr;
                const float w = slot < cnt ? mc.mwt[(size_t)e * T_ + slot] : 0.f;
                bf16_t* rowp = hm + (size_t)(u.rowbase + lr) * MOE_H + f0;
#pragma unroll
                for (int bj = 0; bj < 2; ++bj) { const f32x4 gt = acc[ai][bj][m][0], up = acc[ai][bj][m][1]; f32x4 o;
#pragma unroll
                    for (int j = 0; j < 4; ++j) o[j] = slot < cnt ? gt[j] * sigmoidf_(gt[j]) * up[j] * w : 0.f;
                    u32x2 pk; pk.x = cvt_pk_bf16(o[0], o[1]); pk.y = cvt_pk_bf16(o[2], o[3]);
                    *(u32x2*)(rowp + bj * 64) = pk; } }
    } break;
    case E_DOWN: {
        bf16_t* yd = (bf16_t*)g.C;
        const int lr0 = wr * 64 + fr;
#pragma unroll
        for (int ai = 0; ai < 2; ++ai)
#pragma unroll
            for (int m = 0; m < 4; ++m) { bf16_t* rowp = yd + (size_t)(u.rowbase + lr0 + ai * HALF + m * 16) * DM + colp;
#pragma unroll
                for (int bj = 0; bj < 2; ++bj) *(u32x4*)(rowp + bj * HALF) = pack8(acc[ai][bj][m][0], acc[ai][bj][m][1]); }
    } break;
    default: break;
    }
}

__device__ __forceinline__ void gemm_run(LAS unsigned char* lds, const UnitSrc& S, const MoeCtx& mc) {
    int tid = threadIdx.x; asm volatile("" : "+v"(tid));
    const int wid = __builtin_amdgcn_readfirstlane(tid >> 6), lane = tid & 63, wr = wid >> 2, wc = wid & 3, fr = lane & 15, fq = lane >> 4;
    unsigned voffA[2], voffB[2];
    const unsigned ldsw = (unsigned)wid * 1024u;
    const int aoff = lds_byte(wr * 64 + fr, fq * 8), boff = lds_byte(wc * 32 + fr, fq * 8);
#define G8_VOFF(u) do { _Pragma("unroll") for (int _i = 0; _i < 2; ++_i) { int _R, _C; stage_rc(tid * 16 + _i * 8192, _R, _C); \
        const int _Rb = (u).perm ? ((_R & ~31) + perm32(_R & 31)) : _R; voffB[_i] = (unsigned)_Rb * (u).ldb2 + (unsigned)_C * 2u; voffA[_i] = (unsigned)_R * (u).lda2 + (unsigned)_C * 2u; } } while (0)
#define G8_SA(b, h) (((b) * 2 + (h)) * HTB)
#define G8_SB(b, h) ((4 + (b) * 2 + (h)) * HTB)
#define G8_STAGE(bufoff, gbase, voff) do { _Pragma("unroll") for (int _i = 0; _i < 2; ++_i) \
        __builtin_amdgcn_global_load_lds((const unsigned*)((const char*)(gbase) + (voff)[_i]), (LAS unsigned*)(lds + (bufoff) + ldsw + _i * 8192), 16, 0, 0); } while (0)
#define G8_LDA(dst, b, h) do { _Pragma("unroll") for (int m = 0; m < 4; ++m) _Pragma("unroll") for (int k = 0; k < 2; ++k) dst[m][k] = *(const LAS bf16x8*)(lds + G8_SA(b, h) + aoff + m * 2048 + k * 1024); } while (0)
#define G8_LDB(dst, b, h) do { _Pragma("unroll") for (int n = 0; n < 2; ++n) _Pragma("unroll") for (int k = 0; k < 2; ++k) dst[n][k] = *(const LAS bf16x8*)(lds + G8_SB(b, h) + boff + n * 2048 + k * 1024); } while (0)
#define G8_MMA(ai, bj, At, Bt) do { __builtin_amdgcn_s_setprio(1); _Pragma("unroll") for (int m = 0; m < 4; ++m) _Pragma("unroll") for (int n = 0; n < 2; ++n) _Pragma("unroll") for (int k = 0; k < 2; ++k) \
        acc[ai][bj][m][n] = __builtin_amdgcn_mfma_f32_16x16x32_bf16(Bt[n][k], At[m][k], acc[ai][bj][m][n], 0, 0, 0); __builtin_amdgcn_s_setprio(0); } while (0)
#define G8_WAIT_V(n) asm volatile("s_waitcnt vmcnt(" #n ")" ::: "memory")
#define G8_WAIT_L(n) asm volatile("s_waitcnt lgkmcnt(" #n ")" ::: "memory")
#define G8_BAR __builtin_amdgcn_s_barrier()
#define G8_SCHED __builtin_amdgcn_sched_barrier(0)
    UnitRef cur, nxt; int ui = 0;
    if (!S.get(0, cur)) return;
    f32x4 acc[2][2][4][2];
#pragma unroll
    for (int a = 0; a < 2; ++a)
#pragma unroll
        for (int b = 0; b < 2; ++b)
#pragma unroll
            for (int m = 0; m < 4; ++m)
#pragma unroll
                for (int n = 0; n < 2; ++n) acc[a][b][m][n] = (f32x4){0.f, 0.f, 0.f, 0.f};
    bf16x8 At[4][2], B0[2][2], B1[2][2];
    const char* cA = cur.A; const char* cB = cur.B; size_t chB = (size_t)HALF * cur.ldb2, chA = (size_t)HALF * cur.lda2;
    G8_VOFF(cur);
    const size_t kstep = (size_t)(BK * 2);
    G8_STAGE(G8_SB(0, 0), cB, voffB); G8_STAGE(G8_SA(0, 0), cA, voffA); G8_STAGE(G8_SB(0, 1), cB + chB, voffB); G8_STAGE(G8_SA(0, 1), cA + chA, voffA);
    if (wr == 1) G8_BAR;
    G8_WAIT_V(4); G8_BAR;
    G8_STAGE(G8_SB(1, 0), cB + kstep, voffB); G8_STAGE(G8_SA(1, 0), cA + kstep, voffA); G8_STAGE(G8_SB(1, 1), cB + chB + kstep, voffB);
    G8_WAIT_V(6); G8_BAR;
    for (;;) {
        bool has_next = false; const char* nA = cA; const char* nB = cB; size_t nhB = chB, nhA = chA;
        const int nt = cur.nt;
        for (int t = 0; t < nt; t += 2) {
            const bool last = (t == nt - 2);
            if (last) { has_next = S.get(ui + 1, nxt); if (has_next) { nA = nxt.A; nB = nxt.B; nhB = (size_t)HALF * nxt.ldb2; nhA = (size_t)HALF * nxt.lda2; } }
            const char* a1 = cA + (size_t)(t + 1) * kstep;
            const char* a2 = last ? nA : cA + (size_t)(t + 2) * kstep; const char* b2 = last ? nB : cB + (size_t)(t + 2) * kstep;
            const char* a3 = a2 + kstep; const char* b3 = b2 + kstep;
            const size_t hB2 = last ? nhB : chB, hA2 = last ? nhA : chA;
            G8_LDB(B0, 0, 0); G8_SCHED; G8_LDA(At, 0, 0); G8_STAGE(G8_SA(1, 1), a1 + chA, voffA);
            if (last && has_next) { G8_VOFF(nxt); }
            G8_WAIT_L(8); G8_BAR; G8_WAIT_L(0); G8_MMA(0, 0, At, B0); G8_BAR; G8_SCHED;
            G8_LDB(B1, 0, 1); G8_STAGE(G8_SB(0, 0), b2, voffB);
            G8_BAR; G8_WAIT_L(0); G8_MMA(0, 1, At, B1); G8_BAR;
            G8_LDA(At, 0, 1); G8_STAGE(G8_SA(0, 0), a2, voffA);
            G8_BAR; G8_WAIT_L(0); G8_MMA(1, 0, At, B0); G8_BAR; G8_SCHED;
            G8_STAGE(G8_SB(0, 1), b2 + hB2, voffB);
            G8_WAIT_V(6); G8_BAR; G8_MMA(1, 1, At, B1); G8_BAR;
            G8_LDB(B0, 1, 0); G8_SCHED; G8_LDA(At, 1, 0); G8_STAGE(G8_SA(0, 1), a2 + hA2, voffA);
            G8_WAIT_L(8); G8_BAR; G8_WAIT_L(0); G8_MMA(0, 0, At, B0); G8_BAR; G8_SCHED;
            G8_LDB(B1, 1, 1); G8_STAGE(G8_SB(1, 0), b3, voffB);
            G8_BAR; G8_WAIT_L(0); G8_MMA(0, 1, At, B1); G8_BAR;
            G8_LDA(At, 1, 1); G8_STAGE(G8_SA(1, 0), a3, voffA);
            G8_BAR; G8_WAIT_L(0); G8_MMA(1, 0, At, B0); G8_BAR; G8_SCHED;
            G8_STAGE(G8_SB(1, 1), b3 + hB2, voffB);
            G8_WAIT_V(6); G8_BAR; G8_MMA(1, 1, At, B1); G8_BAR;
        }
        { GDesc gd; { const LAS unsigned* sp = (const LAS unsigned*)&S.tab[cur.d]; unsigned* dp = (unsigned*)&gd; _Pragma("unroll") for (int _w = 0; _w < (int)(sizeof(GDesc) / 4); ++_w) dp[_w] = (unsigned)rfl((int)sp[_w]); }
          epilogue(acc, gd, cur, mc, wr, wc, fr, fq); }
        if (!has_next) break;
#pragma unroll
        for (int a = 0; a < 2; ++a)
#pragma unroll
            for (int b = 0; b < 2; ++b)
#pragma unroll
                for (int m = 0; m < 4; ++m)
#pragma unroll
                    for (int n = 0; n < 2; ++n) acc[a][b][m][n] = (f32x4){0.f, 0.f, 0.f, 0.f};
        cur = nxt; cA = nA; cB = nB; chB = nhB; chA = nhA; ++ui;
    }
    G8_WAIT_V(0);
    if (wr == 0) G8_BAR;
    G8_BAR;
#undef G8_VOFF
#undef G8_SA
#undef G8_SB
#undef G8_STAGE
#undef G8_LDA
#undef G8_LDB
#undef G8_MMA
#undef G8_WAIT_V
#undef G8_WAIT_L
#undef G8_BAR
#undef G8_SCHED
}
}

template <class F>
__device__ __forceinline__ void conv_job(const F& f, bf16_t* dst, int N, int K, int ldd, LAS float* tl) {
    OPQ_IDS
    const int tid = TID_;
    const int tn = N / 64, tk = K / 128, nt = tn * tk;
    for (int t = BID_; t < nt; t += NBLK_) {
        const int n0 = (t % tn) * 64, k0 = (t / tn) * 128;
        __syncthreads();
#pragma unroll 4
        for (int i = 0; i < 16; ++i) { const int idx = tid + i * 512; const int kk = idx >> 6, nn = idx & 63; tl[kk * 65 + nn] = f(n0 + nn, k0 + kk); }
        __syncthreads();
#pragma unroll
        for (int i = 0; i < 2; ++i) { const int idx = tid + i * 512; const int nn = idx >> 4, k8 = idx & 15;
            float v[8];
#pragma unroll
            for (int j = 0; j < 8; ++j) v[j] = tl[(k8 * 8 + j) * 65 + nn];
            u32x4 w; w.x = cvt_pk_bf16(v[0], v[1]); w.y = cvt_pk_bf16(v[2], v[3]); w.z = cvt_pk_bf16(v[4], v[5]); w.w = cvt_pk_bf16(v[6], v[7]);
            *(u32x4*)(dst + (size_t)(n0 + nn) * ldd + k0 + k8 * 8) = w; }
    }
}

__device__ __forceinline__ int win_map(int n) { if (n < C_CC) return n; if (n < C_GL) return n + 12; if (n < C_GL + 12) return n - C_GL + 1888; return -1; }

__device__ __forceinline__ void phase_convert(const Params& P, int l, LAS float* tl) {
    unsigned char* ws = P.ws; asm volatile("" : "+s"(ws));
    { const float* w = P.in[2] + (size_t)l * DM * NIN;
      conv_job([=](int n, int k) -> float { const int c = win_map(n); return c >= 0 ? w[(size_t)k * NIN + c] : 0.f; }, (bf16_t*)(ws + WS.win), NINP, DM, DM, tl); }
    { const float* w = P.in[24] + (size_t)l * DM * DM;
      conv_job([=](int n, int k) -> float { return w[(size_t)k * DM + n]; }, (bf16_t*)(ws + WS.wout), DM, DM, DM, tl); }
    { const float* w = P.in[5] + (size_t)l * 448 * 512;
      conv_job([=](int n, int k) -> float { return k < 448 ? w[(size_t)k * 512 + n] : 0.f; }, (bf16_t*)(ws + WS.wuq), 512, 512, 512, tl); }
    { const float* w = P.in[6] + (size_t)l * 128 * 896;
      conv_job([=](int n, int k) -> float { int c; if (n < 512) { const int h = n >> 7, j = n & 127; c = j < 96 ? h * 224 + j : -1; } else { const int h = (n - 512) >> 7, j = n & 127; c = h * 224 + 96 + j; }
                                            return (k < 128 && c >= 0) ? w[(size_t)k * 896 + c] : 0.f; }, (bf16_t*)(ws + WS.wukv), 1024, 256, 256, tl); }
    for (int kv = 0; kv < 2; ++kv) { const float* w = P.in[8] + ((size_t)l * 2 + kv) * 4096 * 128;
      conv_job([=](int n, int k) -> float { return n < 128 ? w[(size_t)k * 128 + n] : w[(size_t)(2048 + k) * 128 + (n - 128)]; }, (bf16_t*)(ws + WS.wcmp1) + (size_t)kv * 256 * 2048, 256, 2048, 2048, tl); }
    { const float* w = P.in[10] + (size_t)l * 4 * 128 * 128;
      conv_job([=](int n, int k) -> float { const int gi = n >> 7; return (k >> 7) == gi ? w[((size_t)gi * 128 + (k & 127)) * 128 + (n & 127)] : 0.f; }, (bf16_t*)(ws + WS.wpool), 512, 512, 512, tl); }
    { const float* w = P.in[21] + (size_t)l * 512 * 512;
      conv_job([=](int n, int k) -> float { return w[(size_t)k * 512 + n]; }, (bf16_t*)(ws + WS.wglu), 512, 512, 512, tl); }
    { const float* wg = P.in[26] + (size_t)l * DM * 4; const float* we = P.in[28] + (size_t)l * DM * 32;
      conv_job([=](int n, int k) -> float { return n < 4 ? wg[(size_t)k * 4 + n] : (n < 36 ? we[(size_t)k * 32 + (n - 4)] : 0.f); }, (bf16_t*)(ws + WS.wrt), 256, DM, DM, tl); }
    { const float* wg = P.in[30] + (size_t)l * NEXP * DM * MOE_H; const float* wu = P.in[31] + (size_t)l * NEXP * DM * MOE_H;
      conv_job([=](int n, int k) -> float { const int e = n >> 10, nn = n & 1023, f = (nn >> 5) * 16 + (nn & 15); const float* s = (nn & 16) ? wu : wg; return s[((size_t)e * DM + k) * MOE_H + f]; },
               (bf16_t*)(ws + WS.wgu), NEXP * 1024, DM, DM, tl); }
    { const float* wd = P.in[32] + (size_t)l * NEXP * MOE_H * DM;
      conv_job([=](int n, int k) -> float { const int e = n >> 11, d = n & 2047; return wd[((size_t)e * MOE_H + k) * DM + d]; }, (bf16_t*)(ws + WS.wdn), NEXP * DM, MOE_H, MOE_H, tl); }
}

struct S5P { float lr, li, dt, cr, ci; };
__device__ __forceinline__ S5P s5_param(const Params& P, int l, int g, int p) {
    S5P s; s.lr = P.in[13][((size_t)l * 32 + g) * 64 + p]; s.li = P.in[14][((size_t)l * 32 + g) * 64 + p]; s.dt = __expf(P.in[15][(size_t)l * 32 + g]);
    const float mag = __expf(s.lr * s.dt); float sn, cs; sincos_r(s.li * s.dt, &sn, &cs);
    const float ar = mag * cs, ai = mag * sn, den = s.lr * s.lr + s.li * s.li, nr = ar - 1.f, ni = ai;
    s.cr = (nr * s.lr + ni * s.li) / den; s.ci = (ni * s.lr - nr * s.li) / den; return s;
}
__device__ __forceinline__ void s5_apow(const S5P& s, int d, float& r, float& i) { const float mag = __expf((float)d * s.lr * s.dt); float sn, cs; sincos_r((float)d * (s.li * s.dt), &sn, &cs); r = mag * cs; i = mag * sn; }

__device__ __forceinline__ void phase_precompute(const Params& P, int l) {
    OPQ_IDS
    unsigned char* ws = P.ws; asm volatile("" : "+s"(ws)); const int gtid = BID_ * 512 + TID_, gsz = NBLK_ * 512;
    float* rope = (float*)(ws + WS.rope);
    for (int i = gtid; i < S_ * 16; i += gsz) { const int s = i >> 4, j = i & 15; const float inv = exp2f(-(float)j * (1.f / 16.f) * 18.931568569324174f); const float ang = (float)s * inv; float sn, cs; sincos_r(ang, &sn, &cs); rope[s * 32 + j] = cs; rope[s * 32 + 16 + j] = sn; }
    { const int wv = gtid >> 6, lane = TID_ & 63, nwv = gsz >> 6;
      for (int o = wv; o < 256; o += nwv) { const int kv = o >> 7, j = o & 127; const float* pe = P.in[7] + ((size_t)l * 2 + kv) * 4096; const float* w1 = P.in[8] + ((size_t)l * 2 + kv) * 4096 * 128;
          float s = 0.f; for (int k = lane; k < 4096; k += 64) s += pe[k] * w1[(size_t)k * 128 + j]; s = wave_sum(s); if (lane == 0) ((float*)(ws + WS.cmpb1))[o] = s; } }
    float* km = (float*)(ws + WS.s5pow);
    for (int i = gtid; i < 32 * 32 * 256; i += gsz) { const int c2 = i & 15, c = (i >> 4) & 15, d = (i >> 8) & 31, g = i >> 13;
        float acc = 0.f;
        for (int p = 0; p < 64; ++p) { const S5P s = s5_param(P, l, g, p); float pr, pi; s5_apow(s, d, pr, pi);
            const float br = P.in[16][(((size_t)l * 32 + g) * 64 + p) * 16 + c2], bi = P.in[17][(((size_t)l * 32 + g) * 64 + p) * 16 + c2];
            const float bbr = s.cr * br - s.ci * bi, bbi = s.cr * bi + s.ci * br;
            const float xr = pr * bbr - pi * bbi, xi = pr * bbi + pi * bbr;
            const float cre = P.in[18][(((size_t)l * 32 + g) * 16 + c) * 64 + p], cim = P.in[19][(((size_t)l * 32 + g) * 16 + c) * 64 + p];
            acc += cre * xr - cim * xi; }
        if (d == 0 && c == c2) acc += P.in[20][(size_t)l * 512 + g * 16 + c];
        km[i] = acc; }
    bf16_t* wt = (bf16_t*)(ws + WS.s5w);
    for (int i = gtid; i < 32 * 256 * 512; i += gsz) { const int k = i & 511, n = (i >> 9) & 255, g = i >> 17; float v = 0.f;
        if (n < 128) { const int p = n & 63, s_ = k >> 4, c2 = k & 15; const S5P s = s5_param(P, l, g, p); float pr, pi; s5_apow(s, 31 - s_, pr, pi);
            const float br = P.in[16][(((size_t)l * 32 + g) * 64 + p) * 16 + c2], bi = P.in[17][(((size_t)l * 32 + g) * 64 + p) * 16 + c2];
            const float bbr = s.cr * br - s.ci * bi, bbi = s.cr * bi + s.ci * br;
            v = n < 64 ? (pr * bbr - pi * bbi) : (pr * bbi + pi * bbr); }
        wt[i] = f2bf(v); }
    bf16_t* vt = (bf16_t*)(ws + WS.s5v);
    for (int i = gtid; i < 32 * 512 * 256; i += gsz) { const int k = i & 255, n = (i >> 8) & 511, g = i >> 17; float v = 0.f;
        if (k < 128) { const int p = k & 63, t = n >> 4, c = n & 15; const S5P s = s5_param(P, l, g, p); float pr, pi; s5_apow(s, t + 1, pr, pi);
            const float cre = P.in[18][(((size_t)l * 32 + g) * 16 + c) * 64 + p], cim = P.in[19][(((size_t)l * 32 + g) * 16 + c) * 64 + p];
            v = k < 64 ? (cre * pr - cim * pi) : -(cre * pi + cim * pr); }
        vt[i] = f2bf(v); }
}
__device__ __forceinline__ void phase_s5_toeplitz(const Params& P) {
    OPQ_IDS
    unsigned char* ws = P.ws; asm volatile("" : "+s"(ws)); const int gtid = BID_ * 512 + TID_, gsz = NBLK_ * 512;
    const float* km = (const float*)(ws + WS.s5pow); bf16_t* tt = (bf16_t*)(ws + WS.s5t);
    for (int i = gtid; i < 32 * 512 * 64; i += gsz) {
        const int k8 = i & 63, n = (i >> 6) & 511, g = i >> 15; const int t = n >> 4, c = n & 15, s_ = k8 >> 1, c2 = (k8 & 1) * 8;
        float v[8];
#pragma unroll
        for (int j = 0; j < 8; ++j) v[j] = s_ <= t ? km[(((size_t)g * 32 + (t - s_)) * 16 + c) * 16 + c2 + j] : 0.f;
        u32x4 w; w.x = cvt_pk_bf16(v[0], v[1]); w.y = cvt_pk_bf16(v[2], v[3]); w.z = cvt_pk_bf16(v[4], v[5]); w.w = cvt_pk_bf16(v[6], v[7]);
        *(u32x4*)(tt + ((size_t)g * 512 + n) * 512 + k8 * 8) = w; }
}

__device__ __forceinline__ void phase_rmsnorm(const float* x, const float* g, bf16_t* h) {
    OPQ_IDS
    const int lane = TID_ & 63, wv = TID_ >> 6;
    f32x4 gv[8];
#pragma unroll
    for (int i = 0; i < 8; ++i) gv[i] = *(const f32x4*)(g + (i * 64 + lane) * 4);
    for (int r = BID_ * 8 + wv; r < T_; r += NBLK_ * 8) {
        const float* xr = x + (size_t)r * DM; f32x4 v[8]; float ss = 0.f;
#pragma unroll
        for (int i = 0; i < 8; ++i) { v[i] = *(const f32x4*)(xr + (i * 64 + lane) * 4); ss += v[i][0] * v[i][0] + v[i][1] * v[i][1] + v[i][2] * v[i][2] + v[i][3] * v[i][3]; }
        ss = wave_sum(ss); const float rs = rsqrtf(ss * (1.f / DM) + 1e-6f);
#pragma unroll
        for (int i = 0; i < 8; ++i) { u32x2 w; w.x = cvt_pk_bf16(v[i][0] * rs * gv[i][0], v[i][1] * rs * gv[i][1]); w.y = cvt_pk_bf16(v[i][2] * rs * gv[i][2], v[i][3] * rs * gv[i][3]);
            *(u32x2*)(h + (size_t)r * DM + (i * 64 + lane) * 4) = w; }
    }
}

__device__ __forceinline__ void phase_post_inproj(const Params& P, int l) {
    OPQ_IDS
    unsigned char* ws = P.ws; asm volatile("" : "+s"(ws)); const int lane = TID_ & 63, wv = TID_ >> 6;
    bf16_t* cols = (bf16_t*)(ws + WS.cols); const float* rope = (const float*)(ws + WS.rope);
    const float* gq = P.in[3] + (size_t)l * 448; const float* gkv = P.in[4] + (size_t)l * 128;
    bf16_t* cqn = (bf16_t*)(ws + WS.cqn); bf16_t* ckvn = (bf16_t*)(ws + WS.ckvn); bf16_t* krope = (bf16_t*)(ws + WS.krope);
    bf16_t* pd = (bf16_t*)(ws + WS.pd); bf16_t* ud = (bf16_t*)(ws + WS.ud); bf16_t* kcc = (bf16_t*)(ws + WS.kcc); bf16_t* vcc = (bf16_t*)(ws + WS.vcc);
    for (int r = BID_ * 8 + wv; r < T_; r += NBLK_ * 8) {
        const int s = r & (S_ - 1); bf16_t* row = cols + (size_t)r * NINP;
        { float v[8]; float ss = 0.f;
#pragma unroll
          for (int i = 0; i < 8; ++i) { const int c = i * 64 + lane; v[i] = c < 448 ? bf2f(row[C_CQ + c]) : 0.f; ss += v[i] * v[i]; }
          ss = wave_sum(ss); const float rs = rsqrtf(ss * (1.f / 448.f) + 1e-6f);
#pragma unroll
          for (int i = 0; i < 8; ++i) { const int c = i * 64 + lane; cqn[(size_t)r * 512 + c] = c < 448 ? f2bf(v[i] * rs * gq[c]) : (bf16_t)0; } }
        { float v[2]; float ss = 0.f;
#pragma unroll
          for (int i = 0; i < 2; ++i) { v[i] = bf2f(row[C_CKV + i * 64 + lane]); ss += v[i] * v[i]; }
          ss = wave_sum(ss); const float rs = rsqrtf(ss * (1.f / 128.f) + 1e-6f);
#pragma unroll
          for (int i = 0; i < 2; ++i) { const int c = i * 64 + lane; ckvn[(size_t)r * 256 + c] = f2bf(v[i] * rs * gkv[c]); ckvn[(size_t)r * 256 + 128 + c] = 0; } }
        { const int j = lane & 15, which = lane >> 4; const int base = which == 0 ? C_KROPE : (which == 1 ? C_KC : (which == 2 ? C_KS : C_KW));
          const float cs = rope[s * 32 + j], sn = rope[s * 32 + 16 + j]; const float x1 = bf2f(row[base + j]), x2 = bf2f(row[base + 16 + j]);
          const bf16_t o1 = f2bf(x1 * cs - x2 * sn), o2 = f2bf(x2 * cs + x1 * sn);
          if (which == 0) { krope[(size_t)r * 32 + j] = o1; krope[(size_t)r * 32 + 16 + j] = o2; } else { row[base + j] = o1; row[base + 16 + j] = o2; }
          if (which == 1) { kcc[(size_t)r * 128 + j] = o1; kcc[(size_t)r * 128 + 16 + j] = o2; } }
        { kcc[(size_t)r * 128 + 32 + lane] = row[C_KC + 32 + lane]; if (lane < 32) kcc[(size_t)r * 128 + 96 + lane] = row[C_KC + 96 + lane];
          vcc[(size_t)r * 128 + lane] = row[C_VC + lane]; vcc[(size_t)r * 128 + 64 + lane] = row[C_VC + 64 + lane]; }
#pragma unroll
        for (int i = 0; i < 8; ++i) { const int ch = i * 64 + lane; const int w = 2 << (ch >> 7); const int lo = s + 1 - w > 0 ? s + 1 - w : 0; const int cnt = s + 1 - lo;
            float sum = 0.f; for (int q = lo; q <= s; ++q) sum += bf2f(cols[(size_t)(r - s + q) * NINP + C_CC + ch]);
            const float u = bf2f(row[C_CC + ch]); pd[(size_t)r * 512 + ch] = f2bf(sum / (float)cnt - u); }
#pragma unroll
        for (int i = 0; i < 8; ++i) { const int ch = i * 64 + lane; const int g = ch >> 4, c = ch & 15; ud[((size_t)g * S5ROWS + (r >> 5)) * 512 + (r & 31) * 16 + c] = row[C_CD + ch]; }
    }
}

__device__ __forceinline__ void phase_cmp_finish(const Params& P, int l, LAS float* sm) {
    OPQ_IDS
    unsigned char* ws = P.ws; asm volatile("" : "+s"(ws)); const int tid = TID_, sub = tid >> 7, j = tid & 127;
    for (int base = BID_ * 4; base < 2 * NB_ * 128; base += NBLK_ * 4) {
        const int it = base + sub;
        const int kv = it / (NB_ * 128), b = (it / 128) % NB_, n = it & 127;
        const float* z = (const float*)(ws + (kv ? WS.zv : WS.zk)); bf16_t* out = (bf16_t*)(ws + (kv ? WS.vcmp : WS.kcmp)) + ((size_t)b * 128 + n) * 128;
        LAS float* g = sm + sub * 128;
        float hv = 0.f;
        if (n < 127) { const float pre = z[((size_t)b * 128 + n) * 256 + j] + z[((size_t)b * 128 + n + 1) * 256 + 128 + j] + ((const float*)(ws + WS.cmpb1))[kv * 128 + j]; hv = gelu_tanh(pre); }
        __syncthreads();
        g[j] = hv;
        __syncthreads();
        float acc = 0.f;
        if (n < 127) { const float* w2 = P.in[9] + ((size_t)l * 2 + kv) * 128 * 128; for (int k = 0; k < 128; ++k) acc += g[k] * w2[(size_t)k * 128 + j]; }
        out[j] = f2bf(acc);
    }
}

__device__ __forceinline__ void phase_s5_scan(const Params& P, int l) {
    OPQ_IDS
    unsigned char* ws = P.ws; asm volatile("" : "+s"(ws)); const float* xend = (const float*)(ws + WS.xend); bf16_t* xprev = (bf16_t*)(ws + WS.xprev);
    for (int i = BID_ * 512 + TID_; i < NB_ * 32 * 64; i += NBLK_ * 512) { const int p = i & 63, g = (i >> 6) & 31, b = i >> 11;
        const S5P s = s5_param(P, l, g, p); float ar, ai; s5_apow(s, 32, ar, ai); float xr = 0.f, xi = 0.f;
        for (int k = 0; k < 64; ++k) { const size_t row = (size_t)g * S5ROWS + b * 64 + k;
            xprev[row * 256 + p] = f2bf(xr); xprev[row * 256 + 64 + p] = f2bf(xi); xprev[row * 256 + 128 + p] = 0; xprev[row * 256 + 192 + p] = 0;
            const float er = xend[row * 128 + p], ei = xend[row * 128 + 64 + p];
            const float nr = ar * xr - ai * xi + er, ni = ar * xi + ai * xr + ei; xr = nr; xi = ni; } }
}

__device__ __forceinline__ void phase_mixnorm(const Params& P, int l) {
    OPQ_IDS
    unsigned char* ws = P.ws; asm volatile("" : "+s"(ws)); const int lane = TID_ & 63, wv = TID_ >> 6;
    bf16_t* ycat = (bf16_t*)(ws + WS.ycat); const bf16_t* oc = (const bf16_t*)(ws + WS.oc); const bf16_t* os = (const bf16_t*)(ws + WS.os); const bf16_t* ow = (const bf16_t*)(ws + WS.ow);
    const float* g = P.in[23] + (size_t)l * DM;
    for (int r = BID_ * 8 + wv; r < T_; r += NBLK_ * 8) {
#pragma unroll
        for (int grp = 0; grp < 4; ++grp) { float v[8];
            const u32x4 a = *(const u32x4*)(ycat + (size_t)r * DM + grp * 512 + lane * 8);
            v[0] = bflo(a.x); v[1] = bfhi(a.x); v[2] = bflo(a.y); v[3] = bfhi(a.y); v[4] = bflo(a.z); v[5] = bfhi(a.z); v[6] = bflo(a.w); v[7] = bfhi(a.w);
            if (grp == 1) { const u32x4 b = *(const u32x4*)(oc + (size_t)r * 512 + lane * 8), c = *(const u32x4*)(os + (size_t)r * 512 + lane * 8), d = *(const u32x4*)(ow + (size_t)r * 512 + lane * 8);
                v[0] = bflo(b.x) + bflo(c.x) + bflo(d.x); v[1] = bfhi(b.x) + bfhi(c.x) + bfhi(d.x); v[2] = bflo(b.y) + bflo(c.y) + bflo(d.y); v[3] = bfhi(b.y) + bfhi(c.y) + bfhi(d.y);
                v[4] = bflo(b.z) + bflo(c.z) + bflo(d.z); v[5] = bfhi(b.z) + bfhi(c.z) + bfhi(d.z); v[6] = bflo(b.w) + bflo(c.w) + bflo(d.w); v[7] = bfhi(b.w) + bfhi(c.w) + bfhi(d.w); }
            float ss = 0.f;
#pragma unroll
            for (int j = 0; j < 8; ++j) ss += v[j] * v[j];
            ss = wave_sum(ss); const float rs = rsqrtf(ss * (1.f / 512.f) + 1e-6f);
            const f32x4 g0 = *(const f32x4*)(g + grp * 512 + lane * 8), g1 = *(const f32x4*)(g + grp * 512 + lane * 8 + 4);
            u32x4 w; w.x = cvt_pk_bf16(v[0] * rs * g0[0], v[1] * rs * g0[1]); w.y = cvt_pk_bf16(v[2] * rs * g0[2], v[3] * rs * g0[3]);
            w.z = cvt_pk_bf16(v[4] * rs * g1[0], v[5] * rs * g1[1]); w.w = cvt_pk_bf16(v[6] * rs * g1[2], v[7] * rs * g1[3]);
            *(u32x4*)(ycat + (size_t)r * DM + grp * 512 + lane * 8) = w; }
    }
}

__device__ __forceinline__ void phase_route(const Params& P, int l) {
    OPQ_IDS
    unsigned char* ws = P.ws; asm volatile("" : "+s"(ws)); const float* lg = (const float*)(ws + WS.logits); unsigned* cnt = (unsigned*)(ws + WS.ctl) + CW_CNT + l * 64;
    int* mlist = (int*)(ws + WS.mlist); float* mwt = (float*)(ws + WS.mwt); int* mtok = (int*)(ws + WS.mtok);
    const float* bg = P.in[27] + (size_t)l * 4; const float* be = P.in[29] + (size_t)l * 32;
    for (int t = BID_ * 512 + TID_; t < T_; t += NBLK_ * 512) {
        const float* r = lg + (size_t)t * 256;
        float gl[4]; float gm = -1e30f; int gi = 0;
#pragma unroll
        for (int i = 0; i < 4; ++i) { gl[i] = r[i] + bg[i]; if (gl[i] > gm) { gm = gl[i]; gi = i; } }
        float gs = 0.f;
#pragma unroll
        for (int i = 0; i < 4; ++i) gs += __expf(gl[i] - gm);
        const float ptop = 1.f / gs;
        float el[8]; float em = -1e30f;
#pragma unroll
        for (int i = 0; i < 8; ++i) { el[i] = r[4 + gi * 8 + i] + be[gi * 8 + i]; em = fmaxf(em, el[i]); }
        float es = 0.f;
#pragma unroll
        for (int i = 0; i < 8; ++i) { el[i] = __expf(el[i] - em); es += el[i]; }
        float p1 = -1.f, p2 = -1.f; int i1 = 0, i2 = 0;
#pragma unroll
        for (int i = 0; i < 8; ++i) { const float p = el[i]; if (p > p1) { p2 = p1; i2 = i1; p1 = p; i1 = i; } else if (p > p2) { p2 = p; i2 = i; } }
        const float inv = 1.f / (p1 + p2); const float w1 = ptop * p1 * inv, w2 = ptop * p2 * inv;
        const int e1 = gi * 8 + i1, e2 = gi * 8 + i2;
        const int s1 = (int)atomicAdd(&cnt[e1], 1u), s2 = (int)atomicAdd(&cnt[e2], 1u);
        mlist[(size_t)e1 * T_ + s1] = t; mwt[(size_t)e1 * T_ + s1] = w1; mlist[(size_t)e2 * T_ + s2] = t; mwt[(size_t)e2 * T_ + s2] = w2;
        mtok[t * 4 + 0] = e1; mtok[t * 4 + 1] = s1; mtok[t * 4 + 2] = e2; mtok[t * 4 + 3] = s2;
    }
}


__device__ __forceinline__ void phase_moe_gather(const Params& P, const LAS int* tiles, const LAS int* cnt) {
    OPQ_IDS
    unsigned char* ws = P.ws; asm volatile("" : "+s"(ws));
    const int lane = TID_ & 63, wv = TID_ >> 6;
    const int* mlist = (const int*)(ws + WS.mlist); const bf16_t* h = (const bf16_t*)(ws + WS.h); bf16_t* xg = (bf16_t*)(ws + WS_XG);
    const int total = tiles[32] * 256;
    for (int r = BID_ * 8 + wv; r < total; r += NBLK_ * 8) {
        const int tile = r >> 8; int e = 0;
#pragma unroll 1
        while (e < 31 && tile >= tiles[e + 1]) ++e;
        const int slot = r - tiles[e] * 256;
        if (slot < cnt[e]) { const int t = mlist[(size_t)e * T_ + slot];
#pragma unroll
            for (int i = 0; i < 4; ++i) *(u32x4*)(xg + (size_t)r * DM + (i * 64 + lane) * 8) = *(const u32x4*)(h + (size_t)t * DM + (i * 64 + lane) * 8); }
    }
}

__device__ __forceinline__ void phase_combine(const Params& P, int l, const LAS int* tiles, const float* g, bool final_) {
    OPQ_IDS
    unsigned char* ws = P.ws; asm volatile("" : "+s"(ws)); const int lane = TID_ & 63, wv = TID_ >> 6;
    const bf16_t* yd = (const bf16_t*)(ws + WS.yd); const int* mtok = (const int*)(ws + WS.mtok); bf16_t* h = (bf16_t*)(ws + WS.h); float* x = P.out;
    for (int r = BID_ * 8 + wv; r < T_; r += NBLK_ * 8) {
        const int e1 = mtok[r * 4 + 0], s1 = mtok[r * 4 + 1], e2 = mtok[r * 4 + 2], s2 = mtok[r * 4 + 3];
        const size_t c1 = (size_t)tiles[e1] * 256 + s1, c2 = (size_t)tiles[e2] * 256 + s2;
        float v[32]; float ss = 0.f;
#pragma unroll
        for (int i = 0; i < 4; ++i) { const int c = (i * 64 + lane) * 8; const f32x4 x0 = *(const f32x4*)(x + (size_t)r * DM + c), x1 = *(const f32x4*)(x + (size_t)r * DM + c + 4);
            const u32x4 a = *(const u32x4*)(yd + c1 * DM + c), b = *(const u32x4*)(yd + c2 * DM + c);
            v[i * 8 + 0] = x0[0] + bflo(a.x) + bflo(b.x); v[i * 8 + 1] = x0[1] + bfhi(a.x) + bfhi(b.x); v[i * 8 + 2] = x0[2] + bflo(a.y) + bflo(b.y); v[i * 8 + 3] = x0[3] + bfhi(a.y) + bfhi(b.y);
            v[i * 8 + 4] = x1[0] + bflo(a.z) + bflo(b.z); v[i * 8 + 5] = x1[1] + bfhi(a.z) + bfhi(b.z); v[i * 8 + 6] = x1[2] + bflo(a.w) + bflo(b.w); v[i * 8 + 7] = x1[3] + bfhi(a.w) + bfhi(b.w);
#pragma unroll
            for (int j = 0; j < 8; ++j) ss += v[i * 8 + j] * v[i * 8 + j]; }
        ss = wave_sum(ss); const float rs = rsqrtf(ss * (1.f / DM) + 1e-6f);
#pragma unroll
        for (int i = 0; i < 4; ++i) { const int c = (i * 64 + lane) * 8; const f32x4 g0 = *(const f32x4*)(g + c), g1 = *(const f32x4*)(g + c + 4);
            if (final_) { f32x4 o0, o1;
#pragma unroll
                for (int j = 0; j < 4; ++j) { o0[j] = v[i * 8 + j] * rs * g0[j]; o1[j] = v[i * 8 + 4 + j] * rs * g1[j]; }
                *(f32x4*)(x + (size_t)r * DM + c) = o0; *(f32x4*)(x + (size_t)r * DM + c + 4) = o1; }
            else { f32x4 o0, o1;
#pragma unroll
                for (int j = 0; j < 4; ++j) { o0[j] = v[i * 8 + j]; o1[j] = v[i * 8 + 4 + j]; }
                *(f32x4*)(x + (size_t)r * DM + c) = o0; *(f32x4*)(x + (size_t)r * DM + c + 4) = o1;
                u32x4 w; w.x = cvt_pk_bf16(v[i * 8 + 0] * rs * g0[0], v[i * 8 + 1] * rs * g0[1]); w.y = cvt_pk_bf16(v[i * 8 + 2] * rs * g0[2], v[i * 8 + 3] * rs * g0[3]);
                w.z = cvt_pk_bf16(v[i * 8 + 4] * rs * g1[0], v[i * 8 + 5] * rs * g1[1]); w.w = cvt_pk_bf16(v[i * 8 + 6] * rs * g1[2], v[i * 8 + 7] * rs * g1[3]);
                *(u32x4*)(h + (size_t)r * DM + c) = w; } }
    }
}

namespace at {
constexpr int SHM_K = 16384, SHM_V = 16384;
constexpr int OFF_V = 0, OFF_K = 32768, OFF_WS = 65536  , OFF_SEL = 65536 + 2048  , OFF_IMP = 69632  ;
constexpr float SCALE = 0.08838834764831845f, C2 = 1.4426950408889634f * SCALE;
#define KSWZ(row, colB) ((row) * 256 + ((colB) ^ (((row) & 7) << 4)))
__device__ __forceinline__ int v_st(int k, int c) { const int kk = (k & ~0xC) | ((k & 4) << 1) | ((k & 8) >> 1); return ((kk >> 3) * 4 + (c >> 5)) * 512 + ((kk & 7) * 32 + (c & 31)) * 2; }
__device__ __forceinline__ int v_rd_base(int lane) { return ((lane & 3) << 3) | (((lane >> 2) & 3) << 6) | (((lane >> 4) & 1) << 5) | (((lane >> 5) & 1) << 8); }
constexpr int v_rd_off(int d0, int ks, int half) { return d0 * 512 + ks * 4096 + half * 2048; }
__device__ __forceinline__ int crow(int r, int hi) { return (r & 3) + 8 * (r >> 2) + 4 * hi; }

__device__ __forceinline__ void qkt(f32x16& p0, f32x16& p1, const LAS char* Kb, int r32, int hi, const bf16x8* qr) {
    p0 = f32x16{}; p1 = f32x16{};
    const LAS char* kb[4];
#pragma unroll
    for (int dd = 0; dd < 4; ++dd) kb[dd] = Kb + KSWZ(r32, (dd * 16 + hi * 8) * 2);
#pragma unroll
    for (int d0 = 0; d0 < 8; ++d0) { const LAS char* a = kb[d0 & 3] + (d0 >> 2) * 128;
        const bf16x8 b0 = *reinterpret_cast<const LAS bf16x8*>(a);
        const bf16x8 b1 = *reinterpret_cast<const LAS bf16x8*>(a + 32 * 256);
        p0 = __builtin_amdgcn_mfma_f32_32x32x16_bf16(b0, qr[d0], p0, 0, 0, 0);
        p1 = __builtin_amdgcn_mfma_f32_32x32x16_bf16(b1, qr[d0], p1, 0, 0, 0); }
}
__device__ __forceinline__ void pv_tile(f32x16* o, int vb0, bf16x8 pa0, bf16x8 pa1, bf16x8 pa2, bf16x8 pa3) {
#define TRRD(dst, off) asm volatile("ds_read_b64_tr_b16 %0, %1 offset:%2" : "=&v"(dst) : "v"(vb0), "i"(off) : "memory")
#define PV_D0(d0) do { s16x4 l0, l1, l2, l3, h0, h1, h2, h3; constexpr int b_ = v_rd_off(d0, 0, 0); \
        TRRD(l0, b_); TRRD(h0, b_ + 2048); TRRD(l1, b_ + 4096); TRRD(h1, b_ + 6144); TRRD(l2, b_ + 8192); TRRD(h2, b_ + 10240); TRRD(l3, b_ + 12288); TRRD(h3, b_ + 14336); \
        asm volatile("s_waitcnt lgkmcnt(0)" ::: "memory"); __builtin_amdgcn_sched_barrier(0); \
        o[d0] = __builtin_amdgcn_mfma_f32_32x32x16_bf16(pa0, (bf16x8){l0[0], l0[1], l0[2], l0[3], h0[0], h0[1], h0[2], h0[3]}, o[d0], 0, 0, 0); \
        o[d0] = __builtin_amdgcn_mfma_f32_32x32x16_bf16(pa1, (bf16x8){l1[0], l1[1], l1[2], l1[3], h1[0], h1[1], h1[2], h1[3]}, o[d0], 0, 0, 0); \
        o[d0] = __builtin_amdgcn_mfma_f32_32x32x16_bf16(pa2, (bf16x8){l2[0], l2[1], l2[2], l2[3], h2[0], h2[1], h2[2], h2[3]}, o[d0], 0, 0, 0); \
        o[d0] = __builtin_amdgcn_mfma_f32_32x32x16_bf16(pa3, (bf16x8){l3[0], l3[1], l3[2], l3[3], h3[0], h3[1], h3[2], h3[3]}, o[d0], 0, 0, 0); } while (0)
    PV_D0(0); PV_D0(1); PV_D0(2); PV_D0(3);
#undef PV_D0
#undef TRRD
}
__device__ __forceinline__ void mask_tile(f32x16& p0, f32x16& p1, int dq, unsigned W) {
    const float NEG = -__builtin_inff();
#pragma unroll
    for (int r = 0; r < 16; ++r) { const int c = (r & 3) + 8 * (r >> 2);
        if ((unsigned)(dq - c) >= W) p0[r] = NEG;
        if ((unsigned)(dq - c - 32) >= W) p1[r] = NEG; }
}
__device__ __forceinline__ float half_swap_max(float v) { auto rr = __builtin_amdgcn_permlane32_swap(__float_as_uint(v), __float_as_uint(v), false, false); return fmaxf(__uint_as_float(rr[0]), __uint_as_float(rr[1])); }
__device__ __forceinline__ float half_swap_sum(float v) { auto rr = __builtin_amdgcn_permlane32_swap(__float_as_uint(v), __float_as_uint(v), false, false); return __uint_as_float(rr[0]) + __uint_as_float(rr[1]); }
__device__ __forceinline__ void pack_p(const f32x16& p0, const f32x16& p1, bf16x8& pa0, bf16x8& pa1, bf16x8& pa2, bf16x8& pa3) {
#define PK4(P, B_, OUT) do { unsigned a0 = cvt_pk_bf16(P[B_+0], P[B_+1]), a1 = cvt_pk_bf16(P[B_+2], P[B_+3]); \
        unsigned b0 = cvt_pk_bf16(P[B_+4], P[B_+5]), b1 = cvt_pk_bf16(P[B_+6], P[B_+7]); \
        auto r0 = __builtin_amdgcn_permlane32_swap(a0, b0, false, false); auto r1 = __builtin_amdgcn_permlane32_swap(a1, b1, false, false); \
        u32x4 w = {r0[0], r1[0], r0[1], r1[1]}; OUT = *reinterpret_cast<bf16x8*>(&w); } while (0)
    PK4(p0, 0, pa0); PK4(p0, 8, pa1); PK4(p1, 0, pa2); PK4(p1, 8, pa3);
#undef PK4
}

struct Job {
    const bf16_t* Q; int ldq;
    const bf16_t* K; int ldk; const bf16_t* Kalt; int ldkalt;
    const bf16_t* V; int ldv;
    bf16_t* O; int ldo;
    const bf16_t* gate; int ldg, gofs;
    const float* rope; int rope_d0;
    int nsa;
    int head;
    int pos0;
};

__device__ __forceinline__ void load_q(bf16x8* qr, const Job& jb, int qpos, int head, int hi) {
    const bf16_t* qp = jb.Q + (size_t)qpos * jb.ldq + head * 128 + hi * 8;
#pragma unroll
    for (int d0 = 0; d0 < 8; ++d0) qr[d0] = *reinterpret_cast<const bf16x8*>(qp + d0 * 16);
    const float* rp = jb.rope + qpos * 32 + hi * 8;
    f32x4 c0 = *(const f32x4*)rp, c1 = *(const f32x4*)(rp + 4), s0 = *(const f32x4*)(rp + 16), s1 = *(const f32x4*)(rp + 20);
    float cs[8] = {c0[0], c0[1], c0[2], c0[3], c1[0], c1[1], c1[2], c1[3]}, sn[8] = {s0[0], s0[1], s0[2], s0[3], s1[0], s1[1], s1[2], s1[3]};
#define ROPE_AT(D) do { bf16x8 a = qr[D], b = qr[D + 1]; \
        _Pragma("unroll") for (int j = 0; j < 8; ++j) { const float x1 = bf2f((bf16_t)a[j]), x2 = bf2f((bf16_t)b[j]); a[j] = (short)f2bf(x1 * cs[j] - x2 * sn[j]); b[j] = (short)f2bf(x2 * cs[j] + x1 * sn[j]); } \
        qr[D] = a; qr[D + 1] = b; } while (0)
    if (jb.rope_d0 == 0) ROPE_AT(0); else ROPE_AT(6);
#undef ROPE_AT
}

struct Stage { bf16x8 k0, k1, v0, v1; };
__device__ __forceinline__ void stage_load(Stage& st, const Job& jb, int kb, int sr, int sch) {
    const size_t r0 = (size_t)(kb + sr), r1 = (size_t)(kb + 32 + sr);
    if (jb.Kalt && sch >= 12) { st.k0 = *reinterpret_cast<const bf16x8*>(jb.Kalt + r0 * jb.ldkalt + (sch - 12) * 8); st.k1 = *reinterpret_cast<const bf16x8*>(jb.Kalt + r1 * jb.ldkalt + (sch - 12) * 8); }
    else { st.k0 = *reinterpret_cast<const bf16x8*>(jb.K + r0 * jb.ldk + sch * 8); st.k1 = *reinterpret_cast<const bf16x8*>(jb.K + r1 * jb.ldk + sch * 8); }
    st.v0 = *reinterpret_cast<const bf16x8*>(jb.V + r0 * jb.ldv + sch * 8); st.v1 = *reinterpret_cast<const bf16x8*>(jb.V + r1 * jb.ldv + sch * 8);
}
__device__ __forceinline__ void stage_write(const Stage& st, LAS char* lds, int buf, int sr, int sch) {
    LAS char* Kb = lds + OFF_K + buf * SHM_K; LAS char* Vb = lds + OFF_V + buf * SHM_V;
    const int kws = KSWZ(sr, sch * 16);
    *reinterpret_cast<LAS bf16x8*>(Kb + kws) = st.k0; *reinterpret_cast<LAS bf16x8*>(Kb + kws + 32 * 256) = st.k1;
    *reinterpret_cast<LAS bf16x8*>(Vb + v_st(sr, sch * 8)) = st.v0; *reinterpret_cast<LAS bf16x8*>(Vb + v_st(32 + sr, sch * 8)) = st.v1;
}

__device__ __forceinline__ void store_o(const f32x16* o, float l_reg, const Job& jb, LAS float* wsf, int qpos0w, int head, int r32, int hi) {
    float sc = l_reg > 0.f ? 1.f / l_reg : 0.f;
    if (jb.gate) sc *= sigmoidf_(bf2f(jb.gate[(size_t)(qpos0w + r32) * jb.ldg + jb.gofs + 3 * head]));
    if (hi == 0) wsf[r32] = sc;
    asm volatile("s_waitcnt lgkmcnt(0)" ::: "memory");
    bf16_t* Ow = jb.O + (size_t)qpos0w * jb.ldo + head * 128;
#pragma unroll
    for (int r = 0; r < 16; ++r) { const int orow = crow(r, hi); const float s = wsf[orow];
#pragma unroll
        for (int d0 = 0; d0 < 4; ++d0) { const float v = o[d0][r] * s; const float vn = __shfl_xor(v, 1);
            if ((r32 & 1) == 0) *(unsigned*)(Ow + (size_t)orow * jb.ldo + d0 * 32 + r32) = cvt_pk_bf16(v, vn); } }
}

__device__ __forceinline__ void flash(const Job& jb, LAS char* lds, unsigned tiles, unsigned W, bool use_sel) {
    int tid = threadIdx.x; asm volatile("" : "+v"(tid));
    const int wid = __builtin_amdgcn_readfirstlane(tid >> 6), lane = tid & 63, r32 = lane & 31, hi = lane >> 5;
    const int head = jb.nsa ? (wid & 3) : jb.head; const int qpos0w = jb.pos0 + 32 * (jb.nsa ? (wid >> 2) : wid); const int qpos = qpos0w + r32;
    LAS float* wsf = (LAS float*)(lds + OFF_WS) + wid * 64;
    bf16x8 qr[8]; load_q(qr, jb, qpos, head, hi);
    const unsigned rowsel = use_sel ? ((const LAS unsigned*)(lds + OFF_SEL))[qpos - jb.pos0] : 0xffffffffu;
    const int sr = tid >> 4, sch = tid & 15;
    const int vb00 = (int)(uintptr_t)(lds + OFF_V) + v_rd_base(lane);
    float m_reg = -1e30f, l_reg = 0.f; f32x16 o[4] = {};
    Stage st;
    unsigned rem = tiles; int j = __builtin_ctz(rem); rem &= rem - 1; int buf = 0;
    stage_load(st, jb, j * 64, sr, sch);
    __syncthreads();
    stage_write(st, lds, 0, sr, sch);
    __syncthreads();
    for (;;) {
        const bool has_next = rem != 0u; int jn = 0;
        if (has_next) { jn = __builtin_ctz(rem); rem &= rem - 1; stage_load(st, jb, jn * 64, sr, sch); }
        f32x16 p0, p1;
        qkt(p0, p1, lds + OFF_K + buf * SHM_K, r32, hi, qr);
        const int kb = j * 64;
        { const bool rowok = (rowsel >> j) & 1u; const unsigned We = rowok ? W : 0u;
          const bool need = (kb + 63 > qpos0w) || ((long)kb <= (long)qpos0w + 31 - (long)W) || use_sel;
          if (need) mask_tile(p0, p1, qpos - kb - 4 * hi, We); }
        float pmax = p0[0];
#pragma unroll
        for (int r = 1; r < 16; ++r) pmax = fmaxf(pmax, p0[r]);
#pragma unroll
        for (int r = 0; r < 16; ++r) pmax = fmaxf(pmax, p1[r]);
        pmax = half_swap_max(pmax);
        const float mn = fmaxf(m_reg, pmax); const float alpha = __builtin_amdgcn_exp2f((m_reg - mn) * C2); m_reg = mn;
        const float mnL = -mn * C2; float ps = 0.f;
#pragma unroll
        for (int r = 0; r < 16; ++r) { p0[r] = __builtin_amdgcn_exp2f(fmaf(p0[r], C2, mnL)); ps += p0[r]; }
#pragma unroll
        for (int r = 0; r < 16; ++r) { p1[r] = __builtin_amdgcn_exp2f(fmaf(p1[r], C2, mnL)); ps += p1[r]; }
        ps = half_swap_sum(ps); l_reg = l_reg * alpha + ps;
        if (__any(alpha < 1.f)) { if (hi == 0) wsf[32 + r32] = alpha; asm volatile("s_waitcnt lgkmcnt(0)" ::: "memory");
#pragma unroll
            for (int r = 0; r < 16; ++r) { const float a = wsf[32 + crow(r, hi)];
#pragma unroll
                for (int d = 0; d < 4; ++d) o[d][r] *= a; } }
        bf16x8 pa0, pa1, pa2, pa3; pack_p(p0, p1, pa0, pa1, pa2, pa3);
        pv_tile(o, vb00 + buf * SHM_V, pa0, pa1, pa2, pa3);
        if (!has_next) break;
        stage_write(st, lds, buf ^ 1, sr, sch);
        __syncthreads();
        buf ^= 1; j = jn;
    }
    store_o(o, l_reg, jb, wsf, qpos0w, head, r32, hi);
}

__device__ __forceinline__ unsigned cmp_select(const Job& jb, LAS char* lds) {
    int tid = threadIdx.x; asm volatile("" : "+v"(tid));
    const int wid = __builtin_amdgcn_readfirstlane(tid >> 6), lane = tid & 63, r32 = lane & 31, hi = lane >> 5;
    const int head = wid & 3; const int qpos0w = jb.pos0 + 32 * (wid >> 2); const int qpos = qpos0w + r32;
    LAS float* wsf = (LAS float*)(lds + OFF_WS) + wid * 64;
    bf16x8 qr[8]; load_q(qr, jb, qpos, head, hi);
    const int sr = tid >> 4, sch = tid & 15;
    const int vb00 = (int)(uintptr_t)(lds + OFF_V) + v_rd_base(lane);
    Stage s0, s1; stage_load(s0, jb, 0, sr, sch); stage_load(s1, jb, 64, sr, sch);
    __syncthreads();
    stage_write(s0, lds, 0, sr, sch); stage_write(s1, lds, 1, sr, sch);
    __syncthreads();
    f32x16 a0, a1, b0, b1;
    qkt(a0, a1, lds + OFF_K, r32, hi, qr); qkt(b0, b1, lds + OFF_K + SHM_K, r32, hi, qr);
    const int nmax = qpos >= 31 ? ((qpos - 31) >> 4) : -1;
    mask_tile(a0, a1, nmax - 4 * hi, 0x7fffffffu); mask_tile(b0, b1, nmax - 64 - 4 * hi, 0x7fffffffu);
    float pmax = -__builtin_inff();
#pragma unroll
    for (int r = 0; r < 16; ++r) pmax = fmaxf(fmaxf(pmax, a0[r]), fmaxf(a1[r], fmaxf(b0[r], b1[r])));
    pmax = half_swap_max(pmax); if (pmax < -1e37f) pmax = 0.f;
    const float mnL = -pmax * C2; float ps = 0.f;
#pragma unroll
    for (int r = 0; r < 16; ++r) { a0[r] = __builtin_amdgcn_exp2f(fmaf(a0[r], C2, mnL)); a1[r] = __builtin_amdgcn_exp2f(fmaf(a1[r], C2, mnL)); b0[r] = __builtin_amdgcn_exp2f(fmaf(b0[r], C2, mnL)); b1[r] = __builtin_amdgcn_exp2f(fmaf(b1[r], C2, mnL));
        ps += (a0[r] + a1[r]) + (b0[r] + b1[r]); }
    ps = half_swap_sum(ps); const float inv = ps > 0.f ? 1.f / ps : 0.f;
#pragma unroll
    for (int r = 0; r < 16; ++r) { a0[r] *= inv; a1[r] *= inv; b0[r] *= inv; b1[r] *= inv; }
    LAS float* imp = (LAS float*)(lds + OFF_IMP) + (wid * 32 + r32) * 32;
#define GRP(P, gq, i) do { const float s_ = (P[4 * gq] + P[4 * gq + 1]) + (P[4 * gq + 2] + P[4 * gq + 3]); const float pc = __shfl_xor(P[4 * gq + 3], 32); \
        imp[2 * (i) + hi] = s_ + (hi ? pc : pcp); pcp = pc; } while (0)
    { float pcp = 0.f;
      GRP(a0, 0, 0); GRP(a0, 1, 1); GRP(a0, 2, 2); GRP(a0, 3, 3); GRP(a1, 0, 4); GRP(a1, 1, 5); GRP(a1, 2, 6); GRP(a1, 3, 7);
      GRP(b0, 0, 8); GRP(b0, 1, 9); GRP(b0, 2, 10); GRP(b0, 3, 11); GRP(b1, 0, 12); GRP(b1, 1, 13); GRP(b1, 2, 14); GRP(b1, 3, 15); }
#undef GRP
    f32x16 o[4] = {};
    { bf16x8 pa0, pa1, pa2, pa3; pack_p(a0, a1, pa0, pa1, pa2, pa3); pv_tile(o, vb00, pa0, pa1, pa2, pa3);
      pack_p(b0, b1, pa0, pa1, pa2, pa3); pv_tile(o, vb00 + SHM_V, pa0, pa1, pa2, pa3); }
    store_o(o, 1.f, jb, wsf, qpos0w, head, r32, hi);
    __syncthreads();
    unsigned uni = 0u;
    if (tid < 64) { const int q = tid; const int cur = jb.pos0 >> 6;
        LAS float* sc = (LAS float*)(lds + OFF_IMP) + 256 * 32 + q * 33;
        const LAS float* ib = (const LAS float*)(lds + OFF_IMP) + (((q >> 5) * 4) * 32 + (q & 31)) * 32;
        for (int k = 0; k < 32; ++k) { const float v = ib[k] + ib[32 * 32 + k] + ib[2 * 32 * 32 + k] + ib[3 * 32 * 32 + k];
            const bool forced = (k == 0) || (k <= cur && k > cur - 2); sc[k] = forced ? 1e4f : (k <= cur ? v : -1.f); }
        unsigned m = 0u;
        for (int it = 0; it < 8; ++it) { float best = -__builtin_inff(); int bi = 0; for (int k = 0; k < 32; ++k) { const float v = sc[k]; if (v > best) { best = v; bi = k; } } m |= 1u << bi; sc[bi] = -__builtin_inff(); }
        const unsigned valid = cur >= 31 ? 0xffffffffu : ((1u << (cur + 1)) - 1u); m &= valid;
        ((LAS unsigned*)(lds + OFF_SEL))[q] = m;
        unsigned u = m; for (int ofs = 32; ofs > 0; ofs >>= 1) u |= (unsigned)__shfl_xor((int)u, ofs);
        if (q == 0) ((LAS unsigned*)(lds + OFF_SEL))[64] = u; }
    __syncthreads();
    uni = ((const LAS unsigned*)(lds + OFF_SEL))[64];
    return (unsigned)__builtin_amdgcn_readfirstlane((int)uni);
}
}

struct AClass { int type, idx, cost, n; };
struct AOrder { AClass c[72]; };
constexpr AOrder make_aorder() {
    AOrder o{}; int n = 0;
    for (int q = 0; q < 8; ++q) o.c[n++] = AClass{0, q, 4 * (q + 1), 32};
    for (int c = 0; c < 32; ++c) o.c[n++] = AClass{1, c, (c + 1 < 9 ? c + 1 : 9), 8};
    for (int c = 0; c < 32; ++c) o.c[n++] = AClass{2, c, 4 + c, 8};
    for (int i = 1; i < 72; ++i) { AClass k = o.c[i]; int j = i - 1; while (j >= 0 && o.c[j].cost < k.cost) { o.c[j + 1] = o.c[j]; --j; } o.c[j + 1] = k; }
    return o;
}
__device__ const AOrder g_aorder = make_aorder();
constexpr int N_AITEMS = 8 * 32 + 32 * 8 + 32 * 8;

constexpr int LDS_MISC = 131072;
constexpr int LM_BAR = LDS_MISC, LM_Q = LDS_MISC + 16, LM_TILES = LDS_MISC + 64  , LM_CNT = LDS_MISC + 256  , LM_DESC = LDS_MISC + 512;
constexpr int LM_UREC = LDS_MISC + 512 + DEPTH_ * 16 * 160;
constexpr int LDS_BYTES = LM_UREC + 16 * 64;
static_assert(sizeof(g8::GDesc) <= 160, "desc size");

__device__ __forceinline__ void moe_prefix(const Params& P, int l, LAS unsigned char* lds) {
    OPQ_IDS
    __syncthreads();
    if (TID_ == 0) { unsigned* cnt = (unsigned*)(P.ws + WS.ctl) + CW_CNT + l * 64; LAS int* tiles = (LAS int*)(lds + LM_TILES); LAS int* lc = (LAS int*)(lds + LM_CNT); int acc = 0;
        for (int e = 0; e < 32; ++e) { const int c = (int)__hip_atomic_load(cnt + e, __ATOMIC_RELAXED, __HIP_MEMORY_SCOPE_AGENT); lc[e] = c; tiles[e] = acc; acc += (c + 255) >> 8; } tiles[32] = acc; }
    __syncthreads();
}

__device__ __forceinline__ void build_descs(const Params& P, int l, LAS unsigned char* lds) {
    OPQ_IDS
    __syncthreads();
    if (TID_ == 0) {
        unsigned char* ws = P.ws; asm volatile("" : "+s"(ws));
        LAS g8::GDesc* tab = (LAS g8::GDesc*)(lds + LM_DESC + l * 16 * 160); asm volatile("" : "+v"(tab));
        auto mk = [&](int i, const void* A, long long ags, int lda, const void* B, long long bgs, int ldb, int K, int nM, int nN, int nG, int epi, int perm, void* C, long long cgs, int ldc, int coff) {
            LAS g8::GDesc& d = tab[i]; d.A = (const bf16_t*)A; d.B = (const bf16_t*)B; d.a_gs = ags; d.b_gs = bgs; d.lda = lda; d.ldb = ldb; d.K = K; d.nM = nM; d.nN = nN; d.nG = nG; d.epi = epi; d.perm = perm;
            d.C = C; d.c_gs = cgs; d.ldc = ldc; d.coff = coff; d.nvalid = 1 << 30; d.moe = 0; d.v0 = nullptr; d.v1 = nullptr; d.aux = nullptr; d.aux_gs = 0; d.aux_ld = 0; d.X = nullptr; };
        mk(0, ws + WS.h, 0, DM, ws + WS.win, 0, DM, DM, 64, 12, 1, g8::E_BF16, 1, ws + WS.cols, 0, NINP, 0);
        mk(1, ws + WS.cqn, 0, 512, ws + WS.wuq, 0, 512, 512, 64, 2, 1, g8::E_BF16, 1, ws + WS.mq, 0, 512, 0);
        mk(2, ws + WS.ckvn, 0, 256, ws + WS.wukv, 0, 256, 256, 64, 4, 1, g8::E_BF16, 1, ws + WS.mkv, 0, 1024, 0);
        mk(3, ws + WS.kcc, 0, 2048, ws + WS.wcmp1, 0, 2048, 2048, 4, 1, 1, g8::E_F32, 0, ws + WS.zk, 0, 256, 0);
        mk(4, ws + WS.vcc, 0, 2048, (bf16_t*)(ws + WS.wcmp1) + (size_t)256 * 2048, 0, 2048, 2048, 4, 1, 1, g8::E_F32, 0, ws + WS.zv, 0, 256, 0);
        mk(5, ws + WS.pd, 0, 512, ws + WS.wpool, 0, 512, 512, 64, 2, 1, g8::E_POOL, 1, ws + WS.ycat, 0, DM, 1024);
        tab[5].v0 = P.in[11] + (size_t)l * 512; tab[5].v1 = P.in[12] + (size_t)l * 512;
        mk(6, ws + WS.ud, (long long)S5ROWS * 512, 512, ws + WS.s5t, 512 * 512, 512, 512, 2, 2, 32, g8::E_BF16, 1, ws + WS.yintra, (long long)S5ROWS * 512, 512, 0);
        mk(7, ws + WS.ud, (long long)S5ROWS * 512, 512, ws + WS.s5w, 256 * 512, 512, 512, 2, 1, 32, g8::E_F32, 0, ws + WS.xend, (long long)S5ROWS * 128, 128, 0); tab[7].nvalid = 128;
        mk(8, ws + WS.xprev, (long long)S5ROWS * 256, 256, ws + WS.s5v, 512 * 256, 256, 256, 2, 2, 32, g8::E_S5OUT, 1, ws + WS.yg, 0, 512, 0);
        tab[8].aux = (const bf16_t*)(ws + WS.yintra); tab[8].aux_gs = (long long)S5ROWS * 512; tab[8].aux_ld = 512;
        mk(9, ws + WS.yg, 0, 512, ws + WS.wglu, 0, 512, 512, 64, 2, 1, g8::E_GLU, 1, ws + WS.ycat, 0, DM, 1536);
        tab[9].v0 = P.in[22] + (size_t)l * 512; tab[9].aux = (const bf16_t*)(ws + WS.yg); tab[9].aux_ld = 512;
        mk(10, ws + WS.ycat, 0, DM, ws + WS.wout, 0, DM, DM, 64, 8, 1, g8::E_RESID, 0, P.out, 0, DM, 0); tab[10].X = l == 0 ? P.in[0] : P.out;
        mk(11, ws + WS.h, 0, DM, ws + WS.wrt, 0, DM, DM, 64, 1, 1, g8::E_F32, 0, ws + WS.logits, 0, 256, 0);
        mk(12, ws + WS_XG, 0, DM, ws + WS.wgu, (long long)1024 * DM, DM, DM, 0, 4, 32, g8::E_SWIGLU, 0, ws + WS.hmid, 0, MOE_H, 0); tab[12].moe = 1;
        mk(13, ws + WS.hmid, 0, MOE_H, ws + WS.wdn, (long long)DM * MOE_H, MOE_H, MOE_H, 0, 8, 32, g8::E_DOWN, 1, ws + WS.yd, 0, DM, 0); tab[13].moe = 2;
    }
    __syncthreads();
}

__device__ __forceinline__ void run_gemms(const Params& P, LAS unsigned char* lds, int l, int d_lo, int d_hi) {
    LAS unsigned char* lm = lds; asm volatile("" : "+v"(lm));
    g8::UnitSrc S; S.tab = (const LAS g8::GDesc*)(lm + LM_DESC + l * 16 * 160); S.d_lo = d_lo; S.d_hi = d_hi; S.G = gridDim.x; S.c = blockIdx.x; S.moe_tiles = (const LAS int*)(lm + LM_TILES); S.rec = (LAS g8::URec*)(lm + LM_UREC);
    unsigned char* ws = P.ws; asm volatile("" : "+s"(ws));
    g8::MoeCtx mc; mc.cnt = (const LAS int*)(lm + LM_CNT); mc.mlist = (const int*)(ws + WS.mlist); mc.mwt = (const float*)(ws + WS.mwt);
    __syncthreads();
    S.build(mc);
    __syncthreads();
    g8::gemm_run(lds, S, mc);
    __syncthreads();
}

__device__ __forceinline__ void phase_attention(const Params& P, int l, LAS unsigned char* ldsu, LAS unsigned char* ldsv) {
    OPQ_IDS
    unsigned char* ws = P.ws; asm volatile("" : "+s"(ws)); LAS char* lds = (LAS char*)ldsu;
    unsigned* qhead = (unsigned*)(ws + WS.ctl) + CW_QUEUE + l * 64;
    const bf16_t* cols = (const bf16_t*)(ws + WS.cols);
    for (;;) {
        __syncthreads();
        if (TID_ == 0) *(LAS unsigned*)(ldsv + LM_Q) = atomicAdd(qhead, 1u);
        __syncthreads();
        const int item = __builtin_amdgcn_readfirstlane((int)*(const LAS unsigned*)(ldsv + LM_Q));
        if (item >= N_AITEMS) break;
        int rem = item, ci = 0; while (rem >= g_aorder.c[ci].n) { rem -= g_aorder.c[ci].n; ++ci; }
        const int type = g_aorder.c[ci].type, idx = g_aorder.c[ci].idx;
        at::Job jb{}; jb.rope = (const float*)(ws + WS.rope);
        unsigned tiles = 1u, W = 0x7fffffffu; bool use_sel = false;
        if (type == 0) { const int b = rem >> 2, h = rem & 3; const size_t t0 = (size_t)b * S_;
            jb.Q = (const bf16_t*)(ws + WS.mq) + t0 * 512; jb.ldq = 512;
            jb.K = (const bf16_t*)(ws + WS.mkv) + t0 * 1024 + h * 128; jb.ldk = 1024; jb.Kalt = (const bf16_t*)(ws + WS.krope) + t0 * 32; jb.ldkalt = 32;
            jb.V = (const bf16_t*)(ws + WS.mkv) + t0 * 1024 + 512 + h * 128; jb.ldv = 1024;
            jb.O = (bf16_t*)(ws + WS.ycat) + t0 * DM; jb.ldo = DM; jb.gate = nullptr; jb.rope_d0 = 6; jb.nsa = 0; jb.head = h; jb.pos0 = idx * 256;
            const int nt = 4 * (idx + 1); tiles = nt >= 32 ? 0xffffffffu : ((1u << nt) - 1u);
        } else { const int b = rem; const size_t t0 = (size_t)b * S_; const int c = idx;
            jb.Q = cols + t0 * NINP + C_Q; jb.ldq = NINP; jb.Kalt = nullptr; jb.ldkalt = 0; jb.rope_d0 = 0; jb.nsa = 1; jb.head = 0; jb.pos0 = c * 64;
            jb.gate = cols + t0 * NINP + C_GL; jb.ldg = NINP; jb.ldo = 512;
            if (type == 1) {
                jb.K = cols + t0 * NINP + C_KW; jb.ldk = NINP; jb.V = cols + t0 * NINP + C_VW; jb.ldv = NINP; jb.O = (bf16_t*)(ws + WS.ow) + t0 * 512; jb.gofs = 2;
                const int jlo = c - 8 > 0 ? c - 8 : 0; tiles = (c >= 31 ? 0xffffffffu : ((1u << (c + 1)) - 1u)) & ~((1u << jlo) - 1u); W = 512u;
            } else {
                jb.K = (const bf16_t*)(ws + WS.kcmp) + (size_t)b * 128 * 128; jb.ldk = 128; jb.V = (const bf16_t*)(ws + WS.vcmp) + (size_t)b * 128 * 128; jb.ldv = 128;
                jb.O = (bf16_t*)(ws + WS.oc) + t0 * 512; jb.gofs = 0;
                tiles = at::cmp_select(jb, lds); use_sel = true;
                jb.K = cols + t0 * NINP + C_KS; jb.ldk = NINP; jb.V = cols + t0 * NINP + C_VS; jb.ldv = NINP; jb.O = (bf16_t*)(ws + WS.os) + t0 * 512; jb.gofs = 1;
            }
        }
        at::flash(jb, lds, tiles, W, use_sel);
    }
}

constexpr int PH_PER_LAYER = 16, PH_FINAL_BIT = 16;
template <unsigned MASK>
__global__ void __launch_bounds__(512, 2) fwd_kernel(Params P) {
    extern __shared__ __attribute__((aligned(16))) unsigned char smem[];
    LAS unsigned char* lds = (LAS unsigned char*)smem;
    if (threadIdx.x < 4) ((LAS unsigned*)(lds + LM_BAR))[threadIdx.x] = 0u;
    __syncthreads();
    XcdBarrier bar = xcd_barrier_post((unsigned*)(P.ws + WS.ctl) + CW_BAR, (volatile LAS unsigned*)(lds + LM_BAR));
    unsigned char* ws = P.ws; asm volatile("" : "+s"(ws));
    constexpr bool MULTI = (MASK & (MASK - 1)) != 0;
#define PHASE(p) if constexpr ((MASK >> (p)) & 1u)
#define SEAM() do { if constexpr (MULTI) xcd_barrier(bar); } while (0)
    if constexpr (MULTI) xcd_barrier_census(bar);
    for (int l = P.ph_lo; l < P.ph_hi; ++l) build_descs(P, l, lds);
    for (int l = P.ph_lo; l < P.ph_hi; ++l) {
        LAS unsigned char* ldsv = lds;
        PHASE(0) {
            if (l == 0) phase_rmsnorm(P.in[0], P.in[1], (bf16_t*)(ws + WS.h));
            else { moe_prefix(P, l - 1, ldsv); phase_combine(P, l - 1, (const LAS int*)(ldsv + LM_TILES), P.in[1] + (size_t)l * DM, false); }
            phase_convert(P, l, (LAS float*)lds);
            phase_precompute(P, l);
            SEAM(); }
        PHASE(1) { run_gemms(P, lds, l, 0, 1); SEAM(); }
        PHASE(2) { phase_post_inproj(P, l); phase_s5_toeplitz(P); SEAM(); }
        PHASE(3) { run_gemms(P, lds, l, 1, 8); SEAM(); }
        PHASE(4) { phase_cmp_finish(P, l, (LAS float*)lds); phase_s5_scan(P, l); SEAM(); }
        PHASE(5) { run_gemms(P, lds, l, 8, 9); SEAM(); }
        PHASE(6) { phase_attention(P, l, lds, ldsv); SEAM(); }
        PHASE(7) { run_gemms(P, lds, l, 9, 10); SEAM(); }
        PHASE(8) { phase_mixnorm(P, l); SEAM(); }
        PHASE(9) { run_gemms(P, lds, l, 10, 11); SEAM(); }
        PHASE(10) { phase_rmsnorm(P.out, P.in[25] + (size_t)l * DM, (bf16_t*)(ws + WS.h)); SEAM(); }
        PHASE(11) { run_gemms(P, lds, l, 11, 12); SEAM(); }
        PHASE(12) { phase_route(P, l); SEAM(); }
        PHASE(13) { moe_prefix(P, l, ldsv); phase_moe_gather(P, (const LAS int*)(ldsv + LM_TILES), (const LAS int*)(ldsv + LM_CNT)); SEAM(); }
        PHASE(14) { moe_prefix(P, l, ldsv); run_gemms(P, lds, l, 12, 13); SEAM(); }
        PHASE(15) { moe_prefix(P, l, ldsv); run_gemms(P, lds, l, 13, 14); SEAM(); }
    }
    PHASE(PH_FINAL_BIT) { if (P.ph_hi == DEPTH_) { LAS unsigned char* ldsv = lds; moe_prefix(P, DEPTH_ - 1, ldsv); phase_combine(P, DEPTH_ - 1, (const LAS int*)(ldsv + LM_TILES), P.in[33], true); } }
#undef PHASE
#undef SEAM
}

template <unsigned MASK> static void launch_mask(const Params& p, int grid, hipStream_t stream) {
    static bool attr = false;
    if (!attr) { (void)hipFuncSetAttribute((const void*)fwd_kernel<MASK>, hipFuncAttributeMaxDynamicSharedMemorySize, LDS_BYTES); attr = true; }
    hipLaunchKernelGGL(fwd_kernel<MASK>, dim3(grid), dim3(512), LDS_BYTES, stream, p);
}

extern "C" void kernel_launch(void* const* d_in, const int* in_sizes, int n_in, void* d_out, int out_size, void* d_ws, size_t ws_size, hipStream_t stream) {
    static int grid = 0;
    if (grid == 0) {
        if (n_in != 34 || out_size != T_ * DM || ws_size < WS.end) { fprintf(stderr, "kernel_launch: unexpected shapes (n_in %d out %d ws %zu need %zu)\n", n_in, out_size, ws_size, (size_t)WS.end); grid = -1; return; }
        int dev = 0, cus = 0;
        if (hipGetDevice(&dev) != hipSuccess || hipDeviceGetAttribute(&cus, hipDeviceAttributeMultiprocessorCount, dev) != hipSuccess) { grid = -1; return; }
        grid = cus;
    }
    if (grid < 0) return;
    (void)hipMemsetAsync((char*)d_ws + WS.ctl, 0, CTL_BYTES, stream);
    Params p; memset(&p, 0, sizeof(p));
    for (int i = 0; i < 34; ++i) p.in[i] = (const float*)d_in[i];
    p.out = (float*)d_out; p.ws = (unsigned char*)d_ws;
#if N_LAUNCH_SPLIT
    for (int l = 0; l < DEPTH_; ++l) { p.ph_lo = l; p.ph_hi = l + 1;
        launch_mask<1u << 0>(p, grid, stream); launch_mask<1u << 1>(p, grid, stream); launch_mask<1u << 2>(p, grid, stream); launch_mask<1u << 3>(p, grid, stream);
        launch_mask<1u << 4>(p, grid, stream); launch_mask<1u << 5>(p, grid, stream); launch_mask<1u << 6>(p, grid, stream); launch_mask<1u << 7>(p, grid, stream);
        launch_mask<1u << 8>(p, grid, stream); launch_mask<1u << 9>(p, grid, stream); launch_mask<1u << 10>(p, grid, stream); launch_mask<1u << 11>(p, grid, stream);
        launch_mask<1u << 12>(p, grid, stream); launch_mask<1u << 13>(p, grid, stream); launch_mask<1u << 14>(p, grid, stream); launch_mask<1u << 15>(p, grid, stream); }
    p.ph_lo = DEPTH_; p.ph_hi = DEPTH_; launch_mask<1u << 16>(p, grid, stream);
#else
    p.ph_lo = 0; p.ph_hi = DEPTH_; launch_mask<0x1ffffu>(p, grid, stream);
#endif
}
```

```cpp
#include <hip/hip_runtime.h>
#include <stdint.h>
#include <stdio.h>
#include <string.h>

#ifndef REP_MASK
#define REP_MASK 0u
#endif
#ifndef N_LAUNCH_SPLIT
#define N_LAUNCH_SPLIT 0
#endif

#define LAS __attribute__((address_space(3)))
typedef unsigned short bf16_t;
typedef short bf16x8 __attribute__((ext_vector_type(8)));
typedef short s16x4 __attribute__((ext_vector_type(4)));
typedef float f32x4 __attribute__((ext_vector_type(4)));
typedef float f32x16 __attribute__((ext_vector_type(16)));
typedef unsigned u32x4 __attribute__((ext_vector_type(4)));
typedef unsigned u32x2 __attribute__((ext_vector_type(2)));

constexpr int T_ = 16384, S_ = 2048, NB_ = 8, DM = 2048, DEPTH_ = 2;
constexpr int NIN = 2924, NINP = 3072;
constexpr int C_CQ = 0, C_CKV = 448, C_KROPE = 576, C_Q = 608, C_KC = 1120, C_VC = 1248, C_KS = 1376, C_VS = 1504, C_KW = 1632, C_VW = 1760,
              C_CC = 1888, C_CD = 2400, C_GL = 2912;
constexpr int NEXP = 32, MOE_H = 512;
constexpr int MOE_ROWS = 32768 + 32 * 256;
constexpr int S5L = 32, S5ROWS = T_ / S5L;

#define OPQ_IDS int TID_ = threadIdx.x; asm volatile("" : "+v"(TID_)); int BID_ = blockIdx.x; asm volatile("" : "+s"(BID_)); int NBLK_ = gridDim.x; asm volatile("" : "+s"(NBLK_));
__device__ __forceinline__ unsigned cvt_pk_bf16(float lo, float hi) { unsigned r; asm volatile("v_cvt_pk_bf16_f32 %0, %1, %2" : "=v"(r) : "v"(lo), "v"(hi)); return r; }
__device__ __forceinline__ bf16_t f2bf(float f) { return (bf16_t)(cvt_pk_bf16(f, 0.f) & 0xffffu); }
__device__ __forceinline__ float bf2f(bf16_t b) { return __uint_as_float(((unsigned)b) << 16); }
__device__ __forceinline__ float bflo(unsigned w) { return __uint_as_float(w << 16); }
__device__ __forceinline__ float bfhi(unsigned w) { return __uint_as_float(w & 0xffff0000u); }
__device__ __forceinline__ float gelu_tanh(float x) { const float u = 0.7978845608028654f * (x + 0.044715f * x * x * x); const float e = __expf(2.f * u); const float th = 1.f - 2.f / (e + 1.f); return 0.5f * x * (1.f + th); }
__device__ __forceinline__ float sigmoidf_(float x) { return 1.f / (1.f + __expf(-x)); }
__device__ __forceinline__ void sincos_r(float ang, float* s, float* c) { const double rev = (double)ang * 0.15915494309189535; const float fr = (float)(rev - floor(rev)); *s = __builtin_amdgcn_sinf(fr); *c = __builtin_amdgcn_cosf(fr); }
__device__ __forceinline__ float wave_sum(float v) { for (int o = 32; o > 0; o >>= 1) v += __shfl_xor(v, o); return v; }

#define XB_TMO      128
#define XB_XCNT(j)  (256  + 64 * (j))
#define XB_XSUB(j)  (1280 + 64 * (j))
#define XB_XGEN(j)  (2304 + 64 * (j))
#define XB_TOP      3328
#define XB_TOPGEN   3392
#define XCD_BAR_WORDS 3456
#define XB_SPIN_CAP (1u << 22)
__device__ __forceinline__ unsigned xb_ld(unsigned* p)              { return __hip_atomic_load(p, __ATOMIC_RELAXED, __HIP_MEMORY_SCOPE_AGENT); }
__device__ __forceinline__ unsigned xb_add(unsigned* p, unsigned v) { return __hip_atomic_fetch_add(p, v, __ATOMIC_RELAXED, __HIP_MEMORY_SCOPE_AGENT); }
__device__ __forceinline__ unsigned xb_xcc_id() { return (unsigned)__builtin_amdgcn_s_getreg((3 << 11) | 20) & 0xFu; }
#define XB_SPIN(cond, bar) do { unsigned _sp = 0; while (cond) { __builtin_amdgcn_s_sleep(1); \
    if ((++_sp & 255u) == 0u) { if (xb_ld(&(bar)[XB_TMO])) break; if (_sp > XB_SPIN_CAP) { atomicAdd(&(bar)[XB_TMO], 1u); break; } } } } while (0)
struct XcdBarrier { unsigned* bar; unsigned x; volatile LAS unsigned* st; };
__device__ __forceinline__ XcdBarrier xcd_barrier_post(unsigned* bar, volatile LAS unsigned* st) {
    XcdBarrier b; b.bar = bar; b.x = xb_xcc_id(); b.st = st;
    if (threadIdx.x == 0) (void)xb_add(&bar[XB_XCNT(b.x)], 1u);
    return b;
}
__device__ __forceinline__ void xcd_barrier_complete(unsigned* bar, unsigned x, unsigned& nloc, unsigned& nx) {
    const unsigned G = gridDim.x * gridDim.y * gridDim.z;
    unsigned sum, cnt, mine, sp = 0u;
    for (;;) {
        sum = 0u; cnt = 0u; mine = 0u;
#pragma unroll
        for (unsigned j = 0; j < 16; ++j) { const unsigned c = xb_ld(&bar[XB_XCNT(j)]); sum += c; cnt += (c > 0u) ? 1u : 0u; mine = (j == x) ? c : mine; }
        if (sum == G) break;
        __builtin_amdgcn_s_sleep(1);
        if ((++sp & 255u) == 0u) { if (xb_ld(&bar[XB_TMO])) break; if (sp > XB_SPIN_CAP) { atomicAdd(&bar[XB_TMO], 1u); break; } }
    }
    nloc = mine > 0u ? mine : 1u; nx = cnt > 0u ? cnt : 1u;
}
__device__ __forceinline__ void xcd_barrier_census(const XcdBarrier& b) {
    if (threadIdx.x == 0) { unsigned nloc, nx; xcd_barrier_complete(b.bar, b.x, nloc, nx); b.st[0] = nloc; b.st[1] = nx; }
    __syncthreads();
}
__device__ __forceinline__ void xcd_barrier(const XcdBarrier& b) {
    asm volatile("s_waitcnt vmcnt(0)" ::: "memory");
    __syncthreads();
    if (threadIdx.x == 0) {
        unsigned* bar = b.bar;
        __builtin_amdgcn_s_waitcnt(0);
        const unsigned nloc = b.st[0], nx = b.st[1];
        const unsigned old = xb_add(&bar[XB_XSUB(b.x)], 1u);
        const unsigned gen = old / nloc;
        if (old + 1u == (gen + 1u) * nloc) {
            __builtin_amdgcn_fence(__ATOMIC_RELEASE, "agent");
            asm volatile("s_waitcnt vmcnt(0)" ::: "memory");
            const unsigned og = xb_add(&bar[XB_TOP], 1u);
            const unsigned tg = og / nx;
            if (og + 1u == (tg + 1u) * nx) xb_add(&bar[XB_TOPGEN], 1u);
            else XB_SPIN(xb_ld(&bar[XB_TOPGEN]) == tg, bar);
            __builtin_amdgcn_fence(__ATOMIC_ACQUIRE, "agent");
            xb_add(&bar[XB_XGEN(b.x)], 1u);
            asm volatile("s_waitcnt vmcnt(0)" ::: "memory");
        } else {
            XB_SPIN(xb_ld(&bar[XB_XGEN(b.x)]) == gen, bar);
            __builtin_amdgcn_fence(__ATOMIC_ACQUIRE, "agent");
            asm volatile("s_waitcnt vmcnt(0)" ::: "memory");
        }
    }
    __syncthreads();
}

constexpr size_t al256(size_t x) { return (x + 255) & ~(size_t)255; }
struct WsMap {
    size_t ctl, win, wuq, wukv, wcmp1, wpool, wglu, wout, wrt, wgu, wdn, s5t, s5w, s5v, s5pow, cmpb1, rope,
           h, cols, cqn, ckvn, krope, pd, ud, kcc, vcc, mq, mkv, zk, zv, kcmp, vcmp, yintra, xend, xprev, yg, ycat, oc, os, ow,
           logits, mlist, mwt, mtok, hmid, yd, end;
};
constexpr size_t CTL_BYTES = 65536;
constexpr int CW_BAR = 0;
constexpr int CW_CNT = 4096;
constexpr int CW_QUEUE = 4096 + 256;
constexpr int CW_DBG = 8192;
constexpr WsMap make_ws() {
    WsMap w{}; size_t o = 0;
    w.ctl = o; o += CTL_BYTES;
    w.win = o;   o += al256((size_t)NINP * DM * 2);
    w.wuq = o;   o += al256((size_t)512 * 512 * 2);
    w.wukv = o;  o += al256((size_t)1024 * 256 * 2);
    w.wcmp1 = o; o += al256((size_t)2 * 256 * 2048 * 2);
    w.wpool = o; o += al256((size_t)512 * 512 * 2);
    w.wglu = o;  o += al256((size_t)512 * 512 * 2);
    w.wout = o;  o += al256((size_t)DM * DM * 2);
    w.wrt = o;   o += al256((size_t)256 * DM * 2);
    w.wgu = o;   o += al256((size_t)NEXP * 1024 * DM * 2);
    w.wdn = o;   o += al256((size_t)NEXP * DM * MOE_H * 2);
    w.s5t = o;   o += al256((size_t)32 * 512 * 512 * 2);
    w.s5w = o;   o += al256((size_t)32 * 256 * 512 * 2);
    w.s5v = o;   o += al256((size_t)32 * 512 * 256 * 2);
    w.s5pow = o; o += al256((size_t)32 * 32 * 256 * 4);
    w.cmpb1 = o; o += al256((size_t)2 * 128 * 4);
    w.rope = o;  o += al256((size_t)S_ * 32 * 4);
    w.h = o;     o += al256((size_t)T_ * DM * 2);
    w.cols = o;  o += al256((size_t)T_ * NINP * 2);
    w.cqn = o;   o += al256((size_t)T_ * 512 * 2);
    w.ckvn = o;  o += al256((size_t)T_ * 256 * 2);
    w.krope = o; o += al256((size_t)T_ * 32 * 2);
    w.pd = o;    o += al256((size_t)T_ * 512 * 2);
    w.ud = o;    o += al256((size_t)T_ * 512 * 2);
    w.kcc = o;   o += al256((size_t)T_ * 128 * 2);
    w.vcc = o;   o += al256((size_t)T_ * 128 * 2);
    w.mq = o;    o += al256((size_t)T_ * 512 * 2);
    w.mkv = o;   o += al256((size_t)T_ * 1024 * 2);
    w.zk = o;    o += al256((size_t)1024 * 256 * 4);
    w.zv = o;    o += al256((size_t)1024 * 256 * 4);
    w.kcmp = o;  o += al256((size_t)NB_ * 128 * 128 * 2);
    w.vcmp = o;  o += al256((size_t)NB_ * 128 * 128 * 2);
    w.yintra = o; o += al256((size_t)T_ * 512 * 2);
    w.xend = o;  o += al256((size_t)32 * S5ROWS * 128 * 4);
    w.xprev = o; o += al256((size_t)32 * S5ROWS * 256 * 2);
    w.yg = o;    o += al256((size_t)T_ * 512 * 2);
    w.ycat = o;  o += al256((size_t)T_ * DM * 2);
    w.oc = o;    o += al256((size_t)T_ * 512 * 2);
    w.os = o;    o += al256((size_t)T_ * 512 * 2);
    w.ow = o;    o += al256((size_t)T_ * 512 * 2);
    w.logits = o; o += al256((size_t)T_ * 256 * 4);
    w.mlist = o; o += al256((size_t)NEXP * T_ * 4);
    w.mwt = o;   o += al256((size_t)NEXP * T_ * 4);
    w.mtok = o;  o += al256((size_t)T_ * 4 * 4);
    w.hmid = o;  o += al256((size_t)MOE_ROWS * MOE_H * 2);
    w.yd = o;    o += al256((size_t)MOE_ROWS * DM * 2);
    w.end = o;
    return w;
}
constexpr WsMap WS = make_ws();
constexpr size_t WS_XG = WS.cols;
static_assert(WS.zk - WS.cols >= (size_t)MOE_ROWS * DM * 2, "Xg alias");

extern __shared__ __attribute__((aligned(16))) unsigned char smem[];
constexpr int LM_INP_OFF = 131072 + 32;
__device__ __forceinline__ const float* in_ptr(int i) {
    const LAS unsigned* s = (const LAS unsigned*)((LAS unsigned char*)smem + LM_INP_OFF) + 2 * i;
    const unsigned lo = (unsigned)__builtin_amdgcn_readfirstlane((int)s[0]), hi = (unsigned)__builtin_amdgcn_readfirstlane((int)s[1]);
    return (const float*)(((unsigned long long)hi << 32) | lo);
}
struct Params {
    const float* in[34];
    float* out;
    unsigned char* ws;
    int ph_lo, ph_hi;
};

namespace g8 {
constexpr int BM = 256, BK = 64, HALF = 128, HTB = HALF * BK * 2, STAGE_BYTES = 8 * HTB, NXCD = 8, WGM = 8;
__host__ __device__ __forceinline__ int lds_byte(int r, int c) { const int st = (r >> 4) * 2 + (c >> 5), rr = r & 15, cc = c & 31, ob = rr * 64 + cc * 2; return st * 1024 + (ob ^ (((ob >> 9) & 1) << 5)); }
__host__ __device__ __forceinline__ void stage_rc(int b, int& R, int& C) { const int st = b / 1024, sb = b % 1024, swz = sb ^ (((sb >> 9) & 1) << 5); R = (st >> 1) * 16 + swz / 64; C = (st & 1) * 32 + (swz % 64) / 2; }
__host__ __device__ __forceinline__ int perm32(int rho) { const int n = rho >> 4, i = rho & 15; return 8 * (i >> 2) + 4 * n + (i & 3); }

enum { E_BF16 = 0, E_F32 = 1, E_POOL = 2, E_GLU = 3, E_S5OUT = 4, E_RESID = 5, E_SWIGLU = 6, E_DOWN = 7 };

struct GDesc {
    const bf16_t* A; const bf16_t* B;
    long long a_gs, b_gs;
    int lda, ldb, K;
    int nM, nN, nG;
    int epi, perm;
    void* C; long long c_gs; int ldc, coff, nvalid;
    const float* v0; const float* v1;
    const bf16_t* aux; long long aux_gs; int aux_ld;
    const float* X;
    int moe;
};
struct MoeCtx { const LAS int* cnt; const int* mlist; const float* mwt; };
__device__ __forceinline__ int rfl(int v) { return __builtin_amdgcn_readfirstlane(v); }
template <class P> __device__ __forceinline__ P* rflp(P* p) { const unsigned long long a = (unsigned long long)p; const unsigned lo = (unsigned)__builtin_amdgcn_readfirstlane((int)(unsigned)a), hi = (unsigned)__builtin_amdgcn_readfirstlane((int)(unsigned)(a >> 32)); return (P*)(((unsigned long long)hi << 32) | lo); }

struct UnitRef {
    const char* A; const char* B; unsigned lda2, ldb2; int nt;
    int d, grp, pm, pn, perm; int rowbase;
};

constexpr int MAXU = 16;
struct URec { unsigned a_lo, a_hi, b_lo, b_hi, lda2, ldb2, nt, g_lo, g_hi, gcnt, d, grp, pm, pn, perm_valid, rowbase; };
struct UnitSrc {
    const LAS GDesc* tab; int d_lo, d_hi; int G, c;
    const LAS int* moe_tiles;
    LAS URec* rec;
    __device__ __forceinline__ int desc_units(int d) const { const LAS GDesc& g = tab[d]; if (g.moe) return moe_tiles[32] * g.nN; return g.nG * g.nM * g.nN; }
    __device__ __forceinline__ void build(const MoeCtx& mc) const {
        const int i = threadIdx.x;
        if (i < MAXU) {
            URec r{}; r.perm_valid = 0;
            long L = (long)i * G + c; int d = d_lo;
            for (; d < d_hi; ++d) { const int n = desc_units(d); if (L < n) break; L -= n; }
            if (d < d_hi) {
                const LAS GDesc& g = tab[d];
                const int moe = g.moe, nN = g.nN, nM = g.nM; const bf16_t* gA = g.A; const bf16_t* gB = g.B; const long long a_gs = g.a_gs, b_gs = g.b_gs;
                const unsigned lda2 = (unsigned)g.lda * 2u, ldb2 = (unsigned)g.ldb * 2u;
                const char* A; const char* B; int rowbase = 0, grp, pm, pn;
                if (moe) {
                    const int tile = (int)(L / nN); pn = (int)(L % nN);
                    int e = 0;
#pragma unroll 1
                    while (e < 31 && tile >= moe_tiles[e + 1]) ++e;
                    const int mt = tile - moe_tiles[e];
                    grp = e; pm = mt; rowbase = tile * 256;
                    B = (const char*)(gB + (size_t)e * b_gs) + (size_t)pn * 256 * ldb2;
                    A = (const char*)gA + (size_t)tile * 256 * lda2;
                } else {
                    const int per = nM * nN; grp = (int)(L / per); int wgid = (int)(L % per);
                    const int nwg = per; { const int q = nwg / NXCD, rr = nwg % NXCD, xcd = wgid % NXCD, off = wgid / NXCD; wgid = (xcd < rr ? xcd * (q + 1) : rr * (q + 1) + (xcd - rr) * q) + off; }
                    const int nig = WGM * nN, gid = wgid / nig, fm = gid * WGM, gsz = (nM - fm) < WGM ? (nM - fm) : WGM;
                    pm = fm + ((wgid % nig) % gsz); pn = (wgid % nig) / gsz;
                    A = (const char*)(gA + (size_t)grp * a_gs) + (size_t)pm * 256 * lda2;
                    B = (const char*)(gB + (size_t)grp * b_gs) + (size_t)pn * 256 * ldb2;
                }
                r.a_lo = (unsigned)(unsigned long long)A; r.a_hi = (unsigned)((unsigned long long)A >> 32); r.b_lo = (unsigned)(unsigned long long)B; r.b_hi = (unsigned)((unsigned long long)B >> 32);
                r.lda2 = lda2; r.ldb2 = ldb2; r.nt = (unsigned)(g.K / BK); r.g_lo = 0; r.g_hi = 0; r.gcnt = 0;
                r.d = (unsigned)d; r.grp = (unsigned)grp; r.pm = (unsigned)pm; r.pn = (unsigned)pn; r.perm_valid = 2u | (unsigned)(g.perm & 1); r.rowbase = (unsigned)rowbase;
            }
            LAS unsigned* dst = (LAS unsigned*)&rec[i];
            dst[0] = r.a_lo; dst[1] = r.a_hi; dst[2] = r.b_lo; dst[3] = r.b_hi; dst[4] = r.lda2; dst[5] = r.ldb2; dst[6] = r.nt; dst[7] = r.g_lo; dst[8] = r.g_hi; dst[9] = r.gcnt;
            dst[10] = r.d; dst[11] = r.grp; dst[12] = r.pm; dst[13] = r.pn; dst[14] = r.perm_valid; dst[15] = r.rowbase;
        }
    }
    __device__ __forceinline__ bool get(int i, UnitRef& u) const {
        if (i >= MAXU) return false;
        const LAS unsigned* s = (const LAS unsigned*)&rec[i];
        const unsigned pv = (unsigned)rfl((int)s[14]);
        if (!(pv & 2u)) return false;
        const unsigned long long a = ((unsigned long long)(unsigned)rfl((int)s[1]) << 32) | (unsigned)rfl((int)s[0]), b = ((unsigned long long)(unsigned)rfl((int)s[3]) << 32) | (unsigned)rfl((int)s[2]);
        u.A = (const char*)a; u.B = (const char*)b; u.lda2 = (unsigned)rfl((int)s[4]); u.ldb2 = (unsigned)rfl((int)s[5]); u.nt = rfl((int)s[6]);
        u.d = rfl((int)s[10]); u.grp = rfl((int)s[11]); u.pm = rfl((int)s[12]); u.pn = rfl((int)s[13]); u.perm = (int)(pv & 1u); u.rowbase = rfl((int)s[15]);
        return true;
    }
};

__device__ __forceinline__ u32x4 pack8(const f32x4& a, const f32x4& b) { u32x4 w; w.x = cvt_pk_bf16(a[0], a[1]); w.y = cvt_pk_bf16(a[2], a[3]); w.z = cvt_pk_bf16(b[0], b[1]); w.w = cvt_pk_bf16(b[2], b[3]); return w; }

__device__ __forceinline__ void epilogue(const f32x4 (&acc)[2][2][4][2], const GDesc g, const UnitRef& u, const MoeCtx& mc, int wr, int wc, int fr, int fq) {
    const int row0 = u.pm * 256 + wr * 64 + fr;
    const int colp = u.pn * 256 + wc * 32 + 8 * fq;
    const int coln = u.pn * 256 + wc * 32 + 4 * fq;
    switch (g.epi) {
    case E_BF16: {
        bf16_t* base = (bf16_t*)g.C + (size_t)u.grp * g.c_gs + g.coff;
#pragma unroll
        for (int ai = 0; ai < 2; ++ai)
#pragma unroll
            for (int m = 0; m < 4; ++m) { bf16_t* rowp = base + (size_t)(row0 + ai * HALF + m * 16) * g.ldc + colp;
#pragma unroll
                for (int bj = 0; bj < 2; ++bj) *(u32x4*)(rowp + bj * HALF) = pack8(acc[ai][bj][m][0], acc[ai][bj][m][1]); }
    } break;
    case E_F32: {
        float* base = (float*)g.C + (size_t)u.grp * g.c_gs + g.coff;
#pragma unroll
        for (int ai = 0; ai < 2; ++ai)
#pragma unroll
            for (int m = 0; m < 4; ++m) { float* rowp = base + (size_t)(row0 + ai * HALF + m * 16) * g.ldc;
#pragma unroll
                for (int bj = 0; bj < 2; ++bj)
#pragma unroll
                    for (int n = 0; n < 2; ++n) { const int c = coln + bj * HALF + n * 16; if (c < g.nvalid) *(f32x4*)(rowp + c) = acc[ai][bj][m][n]; } }
    } break;
    case E_POOL: {
        bf16_t* base = (bf16_t*)g.C + g.coff;
        f32x4 b0[2][2], s0[2][2];
#pragma unroll
        for (int bj = 0; bj < 2; ++bj)
#pragma unroll
            for (int n = 0; n < 2; ++n) { b0[bj][n] = *(const f32x4*)(g.v0 + colp + bj * HALF + 4 * n); s0[bj][n] = *(const f32x4*)(g.v1 + colp + bj * HALF + 4 * n); }
#pragma unroll
        for (int ai = 0; ai < 2; ++ai)
#pragma unroll
            for (int m = 0; m < 4; ++m) { bf16_t* rowp = base + (size_t)(row0 + ai * HALF + m * 16) * g.ldc + colp;
#pragma unroll
                for (int bj = 0; bj < 2; ++bj) { const f32x4 a = (acc[ai][bj][m][0] + b0[bj][0]) * s0[bj][0], b = (acc[ai][bj][m][1] + b0[bj][1]) * s0[bj][1];
                    *(u32x4*)(rowp + bj * HALF) = pack8(a, b); } }
    } break;
    case E_GLU: {
        bf16_t* base = (bf16_t*)g.C + g.coff;
        f32x4 b0[2][2];
#pragma unroll
        for (int bj = 0; bj < 2; ++bj)
#pragma unroll
            for (int n = 0; n < 2; ++n) b0[bj][n] = *(const f32x4*)(g.v0 + colp + bj * HALF + 4 * n);
#pragma unroll
        for (int ai = 0; ai < 2; ++ai)
#pragma unroll
            for (int m = 0; m < 4; ++m) { const size_t r = (size_t)(row0 + ai * HALF + m * 16); bf16_t* rowp = base + r * g.ldc + colp;
#pragma unroll
                for (int bj = 0; bj < 2; ++bj) { const u32x4 y = *(const u32x4*)(g.aux + r * g.aux_ld + colp + bj * HALF);
                    const f32x4 z0 = acc[ai][bj][m][0] + b0[bj][0], z1 = acc[ai][bj][m][1] + b0[bj][1];
                    f32x4 a, b;
                    a[0] = bflo(y.x) * sigmoidf_(z0[0]); a[1] = bfhi(y.x) * sigmoidf_(z0[1]); a[2] = bflo(y.y) * sigmoidf_(z0[2]); a[3] = bfhi(y.y) * sigmoidf_(z0[3]);
                    b[0] = bflo(y.z) * sigmoidf_(z1[0]); b[1] = bfhi(y.z) * sigmoidf_(z1[1]); b[2] = bflo(y.w) * sigmoidf_(z1[2]); b[3] = bfhi(y.w) * sigmoidf_(z1[3]);
                    *(u32x4*)(rowp + bj * HALF) = pack8(a, b); } }
    } break;
    case E_S5OUT: {
        bf16_t* yg = (bf16_t*)g.C; const bf16_t* yin = g.aux + (size_t)u.grp * g.aux_gs;
#pragma unroll
        for (int ai = 0; ai < 2; ++ai)
#pragma unroll
            for (int m = 0; m < 4; ++m) { const size_t r = (size_t)(row0 + ai * HALF + m * 16);
#pragma unroll
                for (int bj = 0; bj < 2; ++bj) { const int c = colp + bj * HALF; const u32x4 y = *(const u32x4*)(yin + r * g.aux_ld + c);
                    const f32x4 z0 = acc[ai][bj][m][0], z1 = acc[ai][bj][m][1];
                    f32x4 a, b;
                    a[0] = gelu_tanh(z0[0] + bflo(y.x)); a[1] = gelu_tanh(z0[1] + bfhi(y.x)); a[2] = gelu_tanh(z0[2] + bflo(y.y)); a[3] = gelu_tanh(z0[3] + bfhi(y.y));
                    b[0] = gelu_tanh(z1[0] + bflo(y.z)); b[1] = gelu_tanh(z1[1] + bfhi(y.z)); b[2] = gelu_tanh(z1[2] + bflo(y.w)); b[3] = gelu_tanh(z1[3] + bfhi(y.w));
                    const int t = c >> 4, ch = c & 15;
                    *(u32x4*)(yg + (r * 32 + t) * 512 + 16 * u.grp + ch) = pack8(a, b); } }
    } break;
    case E_RESID: {
        float* base = (float*)g.C; const float* xin = g.X;
#pragma unroll
        for (int ai = 0; ai < 2; ++ai)
#pragma unroll
            for (int m = 0; m < 4; ++m) { const size_t ro = (size_t)(row0 + ai * HALF + m * 16) * g.ldc;
#pragma unroll
                for (int bj = 0; bj < 2; ++bj)
#pragma unroll
                    for (int n = 0; n < 2; ++n) { const int c = coln + bj * HALF + n * 16; *(f32x4*)(base + ro + c) = *(const f32x4*)(xin + ro + c) + acc[ai][bj][m][n]; } }
    } break;
    case E_SWIGLU: {
        bf16_t* hm = (bf16_t*)g.C; const int e = u.grp; const int cnt = rfl(mc.cnt[e]);
        const int f0 = u.pn * 128 + wc * 16 + 4 * fq;
#pragma unroll
        for (int ai = 0; ai < 2; ++ai)
#pragma unroll
            for (int m = 0; m < 4; ++m) { const int lr = wr * 64 + fr + ai * HALF + m * 16; const int slot = u.pm * 256 + lr;
                const float w = slot < cnt ? mc.mwt[(size_t)e * T_ + slot] : 0.f;
                bf16_t* rowp = hm + (size_t)(u.rowbase + lr) * MOE_H + f0;
#pragma unroll
                for (int bj = 0; bj < 2; ++bj) { const f32x4 gt = acc[ai][bj][m][0], up = acc[ai][bj][m][1]; f32x4 o;
#pragma unroll
                    for (int j = 0; j < 4; ++j) o[j] = slot < cnt ? gt[j] * sigmoidf_(gt[j]) * up[j] * w : 0.f;
                    u32x2 pk; pk.x = cvt_pk_bf16(o[0], o[1]); pk.y = cvt_pk_bf16(o[2], o[3]);
                    *(u32x2*)(rowp + bj * 64) = pk; } }
    } break;
    case E_DOWN: {
        bf16_t* yd = (bf16_t*)g.C;
        const int lr0 = wr * 64 + fr;
#pragma unroll
        for (int ai = 0; ai < 2; ++ai)
#pragma unroll
            for (int m = 0; m < 4; ++m) { bf16_t* rowp = yd + (size_t)(u.rowbase + lr0 + ai * HALF + m * 16) * DM + colp;
#pragma unroll
                for (int bj = 0; bj < 2; ++bj) *(u32x4*)(rowp + bj * HALF) = pack8(acc[ai][bj][m][0], acc[ai][bj][m][1]); }
    } break;
    default: break;
    }
}

__device__ __forceinline__ void gemm_run(LAS unsigned char* lds, const UnitSrc& S, const MoeCtx& mc) {
    int tid = threadIdx.x; asm volatile("" : "+v"(tid));
    const int wid = __builtin_amdgcn_readfirstlane(tid >> 6), lane = tid & 63, wr = wid >> 2, wc = wid & 3, fr = lane & 15, fq = lane >> 4;
    unsigned voffA[2], voffB[2];
    const unsigned ldsw = (unsigned)wid * 1024u;
    const int aoff = lds_byte(wr * 64 + fr, fq * 8), boff = lds_byte(wc * 32 + fr, fq * 8);
#define G8_VOFF(u) do { _Pragma("unroll") for (int _i = 0; _i < 2; ++_i) { int _R, _C; stage_rc(tid * 16 + _i * 8192, _R, _C); \
        const int _Rb = (u).perm ? ((_R & ~31) + perm32(_R & 31)) : _R; voffB[_i] = (unsigned)_Rb * (u).ldb2 + (unsigned)_C * 2u; voffA[_i] = (unsigned)_R * (u).lda2 + (unsigned)_C * 2u; } } while (0)
#define G8_SA(b, h) (((b) * 2 + (h)) * HTB)
#define G8_SB(b, h) ((4 + (b) * 2 + (h)) * HTB)
#define G8_STAGE(bufoff, gbase, voff) do { _Pragma("unroll") for (int _i = 0; _i < 2; ++_i) \
        __builtin_amdgcn_global_load_lds((const unsigned*)((const char*)(gbase) + (voff)[_i]), (LAS unsigned*)(lds + (bufoff) + ldsw + _i * 8192), 16, 0, 0); } while (0)
#define G8_LDA(dst, b, h) do { _Pragma("unroll") for (int m = 0; m < 4; ++m) _Pragma("unroll") for (int k = 0; k < 2; ++k) dst[m][k] = *(const LAS bf16x8*)(lds + G8_SA(b, h) + aoff + m * 2048 + k * 1024); } while (0)
#define G8_LDB(dst, b, h) do { _Pragma("unroll") for (int n = 0; n < 2; ++n) _Pragma("unroll") for (int k = 0; k < 2; ++k) dst[n][k] = *(const LAS bf16x8*)(lds + G8_SB(b, h) + boff + n * 2048 + k * 1024); } while (0)
#define G8_MMA(ai, bj, At, Bt) do { __builtin_amdgcn_s_setprio(1); _Pragma("unroll") for (int m = 0; m < 4; ++m) _Pragma("unroll") for (int n = 0; n < 2; ++n) _Pragma("unroll") for (int k = 0; k < 2; ++k) \
        acc[ai][bj][m][n] = __builtin_amdgcn_mfma_f32_16x16x32_bf16(Bt[n][k], At[m][k], acc[ai][bj][m][n], 0, 0, 0); __builtin_amdgcn_s_setprio(0); } while (0)
#define G8_WAIT_V(n) asm volatile("s_waitcnt vmcnt(" #n ")" ::: "memory")
#define G8_WAIT_L(n) asm volatile("s_waitcnt lgkmcnt(" #n ")" ::: "memory")
#define G8_BAR __builtin_amdgcn_s_barrier()
#define G8_SCHED __builtin_amdgcn_sched_barrier(0)
    UnitRef cur, nxt; int ui = 0;
    if (!S.get(0, cur)) return;
    f32x4 acc[2][2][4][2];
#pragma unroll
    for (int a = 0; a < 2; ++a)
#pragma unroll
        for (int b = 0; b < 2; ++b)
#pragma unroll
            for (int m = 0; m < 4; ++m)
#pragma unroll
                for (int n = 0; n < 2; ++n) acc[a][b][m][n] = (f32x4){0.f, 0.f, 0.f, 0.f};
    bf16x8 At[4][2], B0[2][2], B1[2][2];
    const char* cA = cur.A; const char* cB = cur.B; size_t chB = (size_t)HALF * cur.ldb2, chA = (size_t)HALF * cur.lda2;
    G8_VOFF(cur);
    const size_t kstep = (size_t)(BK * 2);
    G8_STAGE(G8_SB(0, 0), cB, voffB); G8_STAGE(G8_SA(0, 0), cA, voffA); G8_STAGE(G8_SB(0, 1), cB + chB, voffB); G8_STAGE(G8_SA(0, 1), cA + chA, voffA);
    if (wr == 1) G8_BAR;
    G8_WAIT_V(4); G8_BAR;
    G8_STAGE(G8_SB(1, 0), cB + kstep, voffB); G8_STAGE(G8_SA(1, 0), cA + kstep, voffA); G8_STAGE(G8_SB(1, 1), cB + chB + kstep, voffB);
    G8_WAIT_V(6); G8_BAR;
    for (;;) {
        bool has_next = false; const char* nA = cA; const char* nB = cB; size_t nhB = chB, nhA = chA;
        const int nt = cur.nt;
        for (int t = 0; t < nt; t += 2) {
            const bool last = (t == nt - 2);
            if (last) { has_next = S.get(ui + 1, nxt); if (has_next) { nA = nxt.A; nB = nxt.B; nhB = (size_t)HALF * nxt.ldb2; nhA = (size_t)HALF * nxt.lda2; } }
            const char* a1 = cA + (size_t)(t + 1) * kstep;
            const char* a2 = last ? nA : cA + (size_t)(t + 2) * kstep; const char* b2 = last ? nB : cB + (size_t)(t + 2) * kstep;
            const char* a3 = a2 + kstep; const char* b3 = b2 + kstep;
            const size_t hB2 = last ? nhB : chB, hA2 = last ? nhA : chA;
            G8_LDB(B0, 0, 0); G8_SCHED; G8_LDA(At, 0, 0); G8_STAGE(G8_SA(1, 1), a1 + chA, voffA);
            if (last && has_next) { G8_VOFF(nxt); }
            G8_WAIT_L(8); G8_BAR; G8_WAIT_L(0); G8_MMA(0, 0, At, B0); G8_BAR; G8_SCHED;
            G8_LDB(B1, 0, 1); G8_STAGE(G8_SB(0, 0), b2, voffB);
            G8_BAR; G8_WAIT_L(0); G8_MMA(0, 1, At, B1); G8_BAR;
            G8_LDA(At, 0, 1); G8_STAGE(G8_SA(0, 0), a2, voffA);
            G8_BAR; G8_WAIT_L(0); G8_MMA(1, 0, At, B0); G8_BAR; G8_SCHED;
            G8_STAGE(G8_SB(0, 1), b2 + hB2, voffB);
            G8_WAIT_V(6); G8_BAR; G8_MMA(1, 1, At, B1); G8_BAR;
            G8_LDB(B0, 1, 0); G8_SCHED; G8_LDA(At, 1, 0); G8_STAGE(G8_SA(0, 1), a2 + hA2, voffA);
            G8_WAIT_L(8); G8_BAR; G8_WAIT_L(0); G8_MMA(0, 0, At, B0); G8_BAR; G8_SCHED;
            G8_LDB(B1, 1, 1); G8_STAGE(G8_SB(1, 0), b3, voffB);
            G8_BAR; G8_WAIT_L(0); G8_MMA(0, 1, At, B1); G8_BAR;
            G8_LDA(At, 1, 1); G8_STAGE(G8_SA(1, 0), a3, voffA);
            G8_BAR; G8_WAIT_L(0); G8_MMA(1, 0, At, B0); G8_BAR; G8_SCHED;
            G8_STAGE(G8_SB(1, 1), b3 + hB2, voffB);
            G8_WAIT_V(6); G8_BAR; G8_MMA(1, 1, At, B1); G8_BAR;
        }
        { GDesc gd; { const LAS unsigned* sp = (const LAS unsigned*)&S.tab[cur.d]; unsigned* dp = (unsigned*)&gd; _Pragma("unroll") for (int _w = 0; _w < (int)(sizeof(GDesc) / 4); ++_w) dp[_w] = (unsigned)rfl((int)sp[_w]); }
          epilogue(acc, gd, cur, mc, wr, wc, fr, fq); }
        if (!has_next) break;
#pragma unroll
        for (int a = 0; a < 2; ++a)
#pragma unroll
            for (int b = 0; b < 2; ++b)
#pragma unroll
                for (int m = 0; m < 4; ++m)
#pragma unroll
                    for (int n = 0; n < 2; ++n) acc[a][b][m][n] = (f32x4){0.f, 0.f, 0.f, 0.f};
        cur = nxt; cA = nA; cB = nB; chB = nhB; chA = nhA; ++ui;
    }
    G8_WAIT_V(0);
    if (wr == 0) G8_BAR;
    G8_BAR;
#undef G8_VOFF
#undef G8_SA
#undef G8_SB
#undef G8_STAGE
#undef G8_LDA
#undef G8_LDB
#undef G8_MMA
#undef G8_WAIT_V
#undef G8_WAIT_L
#undef G8_BAR
#undef G8_SCHED
}
}

template <class F>
__device__ __forceinline__ void conv_job(const F& f, bf16_t* dst, int N, int K, int ldd, LAS unsigned char* tb0) {
    OPQ_IDS
    const int lane = TID_ & 63, wv = TID_ >> 6;
    LAS unsigned char* tb = tb0 + wv * (64 * 136);
    const int tn = N / 64, tk = K / 64, nt = tn * tk;
    for (int t = BID_ * 8 + wv; t < nt; t += NBLK_ * 8) {
        const int n0 = (t % tn) * 64, k0 = (t / tn) * 64;
        f32x4 va[8], vb[8];
#pragma unroll
        for (int i = 0; i < 8; ++i) { const int idx = lane + i * 64; const int n4 = (idx & 15) * 4, kp = idx >> 4;
            const float* p0 = f(n0 + n4, k0 + 2 * kp); const float* p1 = f(n0 + n4, k0 + 2 * kp + 1);
            va[i] = p0 ? *(const f32x4*)p0 : (f32x4){0.f, 0.f, 0.f, 0.f}; vb[i] = p1 ? *(const f32x4*)p1 : (f32x4){0.f, 0.f, 0.f, 0.f}; }
#pragma unroll
        for (int i = 0; i < 8; ++i) { const int idx = lane + i * 64; const int n4 = (idx & 15) * 4, kp = idx >> 4;
#pragma unroll
            for (int j = 0; j < 4; ++j) *(LAS unsigned*)(tb + (n4 + j) * 136 + kp * 4) = cvt_pk_bf16(va[i][j], vb[i][j]); }
        asm volatile("s_waitcnt lgkmcnt(0)" ::: "memory");
#pragma unroll
        for (int i = 0; i < 8; ++i) { const int idx = lane + i * 64; const int nn = idx >> 3, k8 = idx & 7;
            const u32x2 lo = *(const LAS u32x2*)(tb + nn * 136 + k8 * 16), hi = *(const LAS u32x2*)(tb + nn * 136 + k8 * 16 + 8);
            u32x4 w; w.x = lo.x; w.y = lo.y; w.z = hi.x; w.w = hi.y;
            *(u32x4*)(dst + (size_t)(n0 + nn) * ldd + k0 + k8 * 8) = w; }
        asm volatile("s_waitcnt lgkmcnt(0)" ::: "memory");
    }
}

__device__ __forceinline__ int win_map(int n) { if (n < C_CC) return n; if (n < C_GL) return n + 12; if (n < C_GL + 12) return n - C_GL + 1888; return -1; }

__device__ __forceinline__ void phase_convert(const Params& P, int l, LAS unsigned char* tl) {
    unsigned char* ws = P.ws; asm volatile("" : "+s"(ws));
    { const float* w = in_ptr(2) + (size_t)l * DM * NIN;
      conv_job([=](int n, int k) -> const float* { const int c = win_map(n); return c >= 0 ? w + (size_t)k * NIN + c : nullptr; }, (bf16_t*)(ws + WS.win), NINP, DM, DM, tl); }
    { const float* w = in_ptr(24) + (size_t)l * DM * DM;
      conv_job([=](int n, int k) -> const float* { return w + (size_t)k * DM + n; }, (bf16_t*)(ws + WS.wout), DM, DM, DM, tl); }
    { const float* w = in_ptr(5) + (size_t)l * 448 * 512;
      conv_job([=](int n, int k) -> const float* { return k < 448 ? w + (size_t)k * 512 + n : nullptr; }, (bf16_t*)(ws + WS.wuq), 512, 512, 512, tl); }
    { const float* w = in_ptr(6) + (size_t)l * 128 * 896;
      conv_job([=](int n, int k) -> const float* { int c; if (n < 512) { const int h = n >> 7, j = n & 127; c = j < 96 ? h * 224 + j : -1; } else { const int h = (n - 512) >> 7, j = n & 127; c = h * 224 + 96 + j; }
                                            return (k < 128 && c >= 0) ? w + (size_t)k * 896 + c : nullptr; }, (bf16_t*)(ws + WS.wukv), 1024, 256, 256, tl); }
    for (int kv = 0; kv < 2; ++kv) { const float* w = in_ptr(8) + ((size_t)l * 2 + kv) * 4096 * 128;
      conv_job([=](int n, int k) -> const float* { return n < 128 ? w + (size_t)k * 128 + n : w + (size_t)(2048 + k) * 128 + (n - 128); }, (bf16_t*)(ws + WS.wcmp1) + (size_t)kv * 256 * 2048, 256, 2048, 2048, tl); }
    { const float* w = in_ptr(10) + (size_t)l * 4 * 128 * 128;
      conv_job([=](int n, int k) -> const float* { const int gi = n >> 7; return (k >> 7) == gi ? w + ((size_t)gi * 128 + (k & 127)) * 128 + (n & 127) : nullptr; }, (bf16_t*)(ws + WS.wpool), 512, 512, 512, tl); }
    { const float* w = in_ptr(21) + (size_t)l * 512 * 512;
      conv_job([=](int n, int k) -> const float* { return w + (size_t)k * 512 + n; }, (bf16_t*)(ws + WS.wglu), 512, 512, 512, tl); }
    { const float* wg = in_ptr(26) + (size_t)l * DM * 4; const float* we = in_ptr(28) + (size_t)l * DM * 32;
      conv_job([=](int n, int k) -> const float* { return n < 4 ? wg + (size_t)k * 4 + n : (n < 36 ? we + (size_t)k * 32 + (n - 4) : nullptr); }, (bf16_t*)(ws + WS.wrt), 256, DM, DM, tl); }
    { const float* wg = in_ptr(30) + (size_t)l * NEXP * DM * MOE_H; const float* wu = in_ptr(31) + (size_t)l * NEXP * DM * MOE_H;
      conv_job([=](int n, int k) -> const float* { const int e = n >> 10, nn = n & 1023, f = (nn >> 5) * 16 + (nn & 15); const float* s = (nn & 16) ? wu : wg; return s + ((size_t)e * DM + k) * MOE_H + f; },
               (bf16_t*)(ws + WS.wgu), NEXP * 1024, DM, DM, tl); }
    { const float* wd = in_ptr(32) + (size_t)l * NEXP * MOE_H * DM;
      conv_job([=](int n, int k) -> const float* { const int e = n >> 11, d = n & 2047; return wd + ((size_t)e * MOE_H + k) * DM + d; }, (bf16_t*)(ws + WS.wdn), NEXP * DM, MOE_H, MOE_H, tl); }
}

struct S5P { float lr, li, dt, cr, ci; };
__device__ __forceinline__ S5P s5_param(const Params& P, int l, int g, int p) {
    S5P s; s.lr = in_ptr(13)[((size_t)l * 32 + g) * 64 + p]; s.li = in_ptr(14)[((size_t)l * 32 + g) * 64 + p]; s.dt = __expf(in_ptr(15)[(size_t)l * 32 + g]);
    const float mag = __expf(s.lr * s.dt); float sn, cs; sincos_r(s.li * s.dt, &sn, &cs);
    const float ar = mag * cs, ai = mag * sn, den = s.lr * s.lr + s.li * s.li, nr = ar - 1.f, ni = ai;
    s.cr = (nr * s.lr + ni * s.li) / den; s.ci = (ni * s.lr - nr * s.li) / den; return s;
}
__device__ __forceinline__ void s5_apow(const S5P& s, int d, float& r, float& i) { const float mag = __expf((float)d * s.lr * s.dt); float sn, cs; sincos_r((float)d * (s.li * s.dt), &sn, &cs); r = mag * cs; i = mag * sn; }

__device__ __forceinline__ void phase_precompute(const Params& P, int l, LAS unsigned char* lds) {
    OPQ_IDS
    unsigned char* ws = P.ws; asm volatile("" : "+s"(ws)); const int gtid = BID_ * 512 + TID_, gsz = NBLK_ * 512;
    float* rope = (float*)(ws + WS.rope);
    for (int i = gtid; i < S_ * 16; i += gsz) { const int s = i >> 4, j = i & 15; const float inv = exp2f(-(float)j * (1.f / 16.f) * 18.931568569324174f); const float ang = (float)s * inv; float sn, cs; sincos_r(ang, &sn, &cs); rope[s * 32 + j] = cs; rope[s * 32 + 16 + j] = sn; }
    { const int wv = gtid >> 6, lane = TID_ & 63, nwv = gsz >> 6;
      for (int o = wv; o < 256; o += nwv) { const int kv = o >> 7, j = o & 127; const float* pe = in_ptr(7) + ((size_t)l * 2 + kv) * 4096; const float* w1 = in_ptr(8) + ((size_t)l * 2 + kv) * 4096 * 128;
          float s = 0.f; for (int k = lane; k < 4096; k += 64) s += pe[k] * w1[(size_t)k * 128 + j]; s = wave_sum(s); if (lane == 0) ((float*)(ws + WS.cmpb1))[o] = s; } }
    LAS float* apw = (LAS float*)lds;
    LAS float* bb = apw + 64 * 34 * 2;
    LAS float* cc = bb + 64 * 16 * 2;
    float* km = (float*)(ws + WS.s5pow); bf16_t* wt = (bf16_t*)(ws + WS.s5w); bf16_t* vt = (bf16_t*)(ws + WS.s5v);
    for (int wg = BID_; wg < 32 * 8; wg += NBLK_) { const int g = wg & 31, sub = wg >> 5;
        __syncthreads();
        for (int i = TID_; i < 64 * 34; i += 512) { const int p = i / 34, d = i - p * 34; const S5P s = s5_param(P, l, g, p); float pr, pi; s5_apow(s, d, pr, pi); apw[i * 2] = pr; apw[i * 2 + 1] = pi; }
        for (int i = TID_; i < 64 * 16; i += 512) { const int p = i >> 4, c2 = i & 15; const S5P s = s5_param(P, l, g, p);
            const float br = in_ptr(16)[(((size_t)l * 32 + g) * 64 + p) * 16 + c2], bi = in_ptr(17)[(((size_t)l * 32 + g) * 64 + p) * 16 + c2];
            bb[i * 2] = s.cr * br - s.ci * bi; bb[i * 2 + 1] = s.cr * bi + s.ci * br; }
        for (int i = TID_; i < 16 * 64; i += 512) { cc[i * 2] = in_ptr(18)[((size_t)l * 32 + g) * 1024 + i]; cc[i * 2 + 1] = in_ptr(19)[((size_t)l * 32 + g) * 1024 + i]; }
        __syncthreads();
        for (int i = TID_; i < 4 * 256; i += 512) { const int c2 = i & 15, c = (i >> 4) & 15, d = sub * 4 + (i >> 8);
            float acc = 0.f;
            for (int p = 0; p < 64; ++p) { const float pr = apw[(p * 34 + d) * 2], pi = apw[(p * 34 + d) * 2 + 1], bbr = bb[(p * 16 + c2) * 2], bbi = bb[(p * 16 + c2) * 2 + 1];
                const float xr = pr * bbr - pi * bbi, xi = pr * bbi + pi * bbr; acc += cc[(c * 64 + p) * 2] * xr - cc[(c * 64 + p) * 2 + 1] * xi; }
            if (d == 0 && c == c2) acc += in_ptr(20)[(size_t)l * 512 + g * 16 + c];
            km[(((size_t)g * 32 + d) * 16 + c) * 16 + c2] = acc; }
        for (int i = TID_; i < 32 * 512; i += 512) { const int k = i & 511, n = sub * 32 + (i >> 9); float v = 0.f;
            if (n < 128) { const int p = n & 63, s_ = k >> 4, c2 = k & 15; const float pr = apw[(p * 34 + 31 - s_) * 2], pi = apw[(p * 34 + 31 - s_) * 2 + 1], bbr = bb[(p * 16 + c2) * 2], bbi = bb[(p * 16 + c2) * 2 + 1];
                v = n < 64 ? (pr * bbr - pi * bbi) : (pr * bbi + pi * bbr); }
            wt[((size_t)g * 256 + n) * 512 + k] = f2bf(v); }
        for (int i = TID_; i < 64 * 256; i += 512) { const int k = i & 255, n = sub * 64 + (i >> 8); float v = 0.f;
            if (k < 128) { const int p = k & 63, t = n >> 4, c = n & 15; const float pr = apw[(p * 34 + t + 1) * 2], pi = apw[(p * 34 + t + 1) * 2 + 1], cre = cc[(c * 64 + p) * 2], cim = cc[(c * 64 + p) * 2 + 1];
                v = k < 64 ? (cre * pr - cim * pi) : -(cre * pi + cim * pr); }
            vt[((size_t)g * 512 + n) * 256 + k] = f2bf(v); }
    }
    __syncthreads();
}
__device__ __forceinline__ void phase_s5_toeplitz(const Params& P) {
    OPQ_IDS
    unsigned char* ws = P.ws; asm volatile("" : "+s"(ws)); const int gtid = BID_ * 512 + TID_, gsz = NBLK_ * 512;
    const float* km = (const float*)(ws + WS.s5pow); bf16_t* tt = (bf16_t*)(ws + WS.s5t);
    for (int i = gtid; i < 32 * 512 * 64; i += gsz) {
        const int k8 = i & 63, n = (i >> 6) & 511, g = i >> 15; const int t = n >> 4, c = n & 15, s_ = k8 >> 1, c2 = (k8 & 1) * 8;
        float v[8];
#pragma unroll
        for (int j = 0; j < 8; ++j) v[j] = s_ <= t ? km[(((size_t)g * 32 + (t - s_)) * 16 + c) * 16 + c2 + j] : 0.f;
        u32x4 w; w.x = cvt_pk_bf16(v[0], v[1]); w.y = cvt_pk_bf16(v[2], v[3]); w.z = cvt_pk_bf16(v[4], v[5]); w.w = cvt_pk_bf16(v[6], v[7]);
        *(u32x4*)(tt + ((size_t)g * 512 + n) * 512 + k8 * 8) = w; }
}

__device__ __forceinline__ void phase_rmsnorm(const float* x, const float* g, bf16_t* h) {
    OPQ_IDS
    const int lane = TID_ & 63, wv = TID_ >> 6;
    f32x4 gv[8];
#pragma unroll
    for (int i = 0; i < 8; ++i) gv[i] = *(const f32x4*)(g + (i * 64 + lane) * 4);
    for (int r = BID_ * 8 + wv; r < T_; r += NBLK_ * 8) {
        const float* xr = x + (size_t)r * DM; f32x4 v[8]; float ss = 0.f;
#pragma unroll
        for (int i = 0; i < 8; ++i) { v[i] = *(const f32x4*)(xr + (i * 64 + lane) * 4); ss += v[i][0] * v[i][0] + v[i][1] * v[i][1] + v[i][2] * v[i][2] + v[i][3] * v[i][3]; }
        ss = wave_sum(ss); const float rs = rsqrtf(ss * (1.f / DM) + 1e-6f);
#pragma unroll
        for (int i = 0; i < 8; ++i) { u32x2 w; w.x = cvt_pk_bf16(v[i][0] * rs * gv[i][0], v[i][1] * rs * gv[i][1]); w.y = cvt_pk_bf16(v[i][2] * rs * gv[i][2], v[i][3] * rs * gv[i][3]);
            *(u32x2*)(h + (size_t)r * DM + (i * 64 + lane) * 4) = w; }
    }
}

__device__ __forceinline__ void unpack8(const u32x4 a, float* v) { v[0] = bflo(a.x); v[1] = bfhi(a.x); v[2] = bflo(a.y); v[3] = bfhi(a.y); v[4] = bflo(a.z); v[5] = bfhi(a.z); v[6] = bflo(a.w); v[7] = bfhi(a.w); }
__device__ __forceinline__ u32x4 pack8f(const float* v) { u32x4 w; w.x = cvt_pk_bf16(v[0], v[1]); w.y = cvt_pk_bf16(v[2], v[3]); w.z = cvt_pk_bf16(v[4], v[5]); w.w = cvt_pk_bf16(v[6], v[7]); return w; }
__device__ __forceinline__ void phase_post_inproj(const Params& P, int l) {
    OPQ_IDS
    unsigned char* ws = P.ws; asm volatile("" : "+s"(ws)); const int lane = TID_ & 63, wv = TID_ >> 6;
    bf16_t* cols = (bf16_t*)(ws + WS.cols); const float* rope = (const float*)(ws + WS.rope);
    const float* gq = in_ptr(3) + (size_t)l * 448; const float* gkv = in_ptr(4) + (size_t)l * 128;
    bf16_t* cqn = (bf16_t*)(ws + WS.cqn); bf16_t* ckvn = (bf16_t*)(ws + WS.ckvn); bf16_t* krope = (bf16_t*)(ws + WS.krope);
    bf16_t* pd = (bf16_t*)(ws + WS.pd); bf16_t* ud = (bf16_t*)(ws + WS.ud); bf16_t* kcc = (bf16_t*)(ws + WS.kcc); bf16_t* vcc = (bf16_t*)(ws + WS.vcc);
    const u32x4 zero4 = {0u, 0u, 0u, 0u};
    for (int r = BID_ * 8 + wv; r < T_; r += NBLK_ * 8) {
        const int s = r & (S_ - 1); bf16_t* row = cols + (size_t)r * NINP;
        const u32x4 q8 = lane < 56 ? *(const u32x4*)(row + C_CQ + lane * 8) : zero4;
        const u32x4 kv8 = lane < 16 ? *(const u32x4*)(row + C_CKV + lane * 8) : zero4;
        const u32x4 u8 = *(const u32x4*)(row + C_CC + lane * 8);
        const u32x4 d8 = *(const u32x4*)(row + C_CD + lane * 8);
        const int w = 2 << (lane >> 4);
        u32x4 pw[15];
#pragma unroll
        for (int q = 1; q < 16; ++q) pw[q - 1] = (q < w && s - q >= 0) ? *(const u32x4*)(row - (size_t)q * NINP + C_CC + lane * 8) : zero4;
        const int rt = lane >> 1, rh = lane & 1; const int rbase = rt == 0 ? C_KROPE : (rt == 1 ? C_KC : (rt == 2 ? C_KS : C_KW));
        u32x4 r1 = zero4, r2 = zero4; if (lane < 8) { r1 = *(const u32x4*)(row + rbase + rh * 8); r2 = *(const u32x4*)(row + rbase + 16 + rh * 8); }
        const u32x4 kc8 = (lane >= 4 && lane < 16) ? *(const u32x4*)(row + C_KC + lane * 8) : zero4;
        const u32x4 vc8 = lane < 16 ? *(const u32x4*)(row + C_VC + lane * 8) : zero4;
        { float v[8]; unpack8(q8, v); float ss = 0.f;
#pragma unroll
          for (int j = 0; j < 8; ++j) ss += v[j] * v[j];
          ss = wave_sum(ss); const float rs = rsqrtf(ss * (1.f / 448.f) + 1e-6f);
          if (lane < 56) { const f32x4 g0 = *(const f32x4*)(gq + lane * 8), g1 = *(const f32x4*)(gq + lane * 8 + 4);
#pragma unroll
              for (int j = 0; j < 4; ++j) { v[j] *= rs * g0[j]; v[4 + j] *= rs * g1[j]; } }
          *(u32x4*)(cqn + (size_t)r * 512 + lane * 8) = lane < 56 ? pack8f(v) : zero4; }
        { float v[8]; unpack8(kv8, v); float ss = 0.f;
#pragma unroll
          for (int j = 0; j < 8; ++j) ss += v[j] * v[j];
          ss = wave_sum(ss); const float rs = rsqrtf(ss * (1.f / 128.f) + 1e-6f);
          if (lane < 16) { const f32x4 g0 = *(const f32x4*)(gkv + lane * 8), g1 = *(const f32x4*)(gkv + lane * 8 + 4);
#pragma unroll
              for (int j = 0; j < 4; ++j) { v[j] *= rs * g0[j]; v[4 + j] *= rs * g1[j]; } }
          if (lane < 32) *(u32x4*)(ckvn + (size_t)r * 256 + lane * 8) = lane < 16 ? pack8f(v) : zero4; }
        if (lane < 8) { float x1[8], x2[8], o1[8], o2[8]; unpack8(r1, x1); unpack8(r2, x2);
            const f32x4 c0 = *(const f32x4*)(rope + s * 32 + rh * 8), c1 = *(const f32x4*)(rope + s * 32 + rh * 8 + 4), s0 = *(const f32x4*)(rope + s * 32 + 16 + rh * 8), s1 = *(const f32x4*)(rope + s * 32 + 16 + rh * 8 + 4);
#pragma unroll
            for (int j = 0; j < 8; ++j) { const float cs = j < 4 ? c0[j] : c1[j - 4], sn = j < 4 ? s0[j] : s1[j - 4]; o1[j] = x1[j] * cs - x2[j] * sn; o2[j] = x2[j] * cs + x1[j] * sn; }
            const u32x4 w1 = pack8f(o1), w2 = pack8f(o2);
            if (rt == 0) { *(u32x4*)(krope + (size_t)r * 32 + rh * 8) = w1; *(u32x4*)(krope + (size_t)r * 32 + 16 + rh * 8) = w2; }
            else { *(u32x4*)(row + rbase + rh * 8) = w1; *(u32x4*)(row + rbase + 16 + rh * 8) = w2; }
            if (rt == 1) { *(u32x4*)(kcc + (size_t)r * 128 + rh * 8) = w1; *(u32x4*)(kcc + (size_t)r * 128 + 16 + rh * 8) = w2; } }
        if (lane >= 4 && lane < 16) *(u32x4*)(kcc + (size_t)r * 128 + lane * 8) = kc8;
        if (lane < 16) *(u32x4*)(vcc + (size_t)r * 128 + lane * 8) = vc8;
        { float u[8], acc[8], t[8]; unpack8(u8, u);
#pragma unroll
          for (int j = 0; j < 8; ++j) acc[j] = u[j];
#pragma unroll
          for (int q = 1; q < 16; ++q) { unpack8(pw[q - 1], t);
#pragma unroll
              for (int j = 0; j < 8; ++j) acc[j] += t[j]; }
          const int cnt = s + 1 < w ? s + 1 : w; const float inv = 1.f / (float)cnt;
#pragma unroll
          for (int j = 0; j < 8; ++j) acc[j] = acc[j] * inv - u[j];
          *(u32x4*)(pd + (size_t)r * 512 + lane * 8) = pack8f(acc); }
        *(u32x4*)(ud + ((size_t)(lane >> 1) * S5ROWS + (r >> 5)) * 512 + (r & 31) * 16 + (lane & 1) * 8) = d8;
    }
}

__device__ __forceinline__ void phase_cmp_finish(const Params& P, int l, LAS float* sm) {
    OPQ_IDS
    unsigned char* ws = P.ws; asm volatile("" : "+s"(ws)); const int tid = TID_, sub = tid >> 7, j = tid & 127;
    for (int base = BID_ * 4; base < 2 * NB_ * 128; base += NBLK_ * 4) {
        const int it = base + sub;
        const int kv = it / (NB_ * 128), b = (it / 128) % NB_, n = it & 127;
        const float* z = (const float*)(ws + (kv ? WS.zv : WS.zk)); bf16_t* out = (bf16_t*)(ws + (kv ? WS.vcmp : WS.kcmp)) + ((size_t)b * 128 + n) * 128;
        LAS float* g = sm + sub * 128;
        float hv = 0.f;
        if (n < 127) { const float pre = z[((size_t)b * 128 + n) * 256 + j] + z[((size_t)b * 128 + n + 1) * 256 + 128 + j] + ((const float*)(ws + WS.cmpb1))[kv * 128 + j]; hv = gelu_tanh(pre); }
        __syncthreads();
        g[j] = hv;
        __syncthreads();
        float acc = 0.f;
        if (n < 127) { const float* w2 = in_ptr(9) + ((size_t)l * 2 + kv) * 128 * 128; for (int k = 0; k < 128; ++k) acc += g[k] * w2[(size_t)k * 128 + j]; }
        out[j] = f2bf(acc);
    }
}

__device__ __forceinline__ void phase_s5_scan(const Params& P, int l) {
    OPQ_IDS
    unsigned char* ws = P.ws; asm volatile("" : "+s"(ws)); const float* xend = (const float*)(ws + WS.xend); bf16_t* xprev = (bf16_t*)(ws + WS.xprev);
    for (int i = BID_ * 512 + TID_; i < NB_ * 32 * 64; i += NBLK_ * 512) { const int p = i & 63, g = (i >> 6) & 31, b = i >> 11;
        const S5P s = s5_param(P, l, g, p); float ar, ai; s5_apow(s, 32, ar, ai); float xr = 0.f, xi = 0.f;
        for (int k0 = 0; k0 < 64; k0 += 16) { float er[16], ei[16];
#pragma unroll
            for (int k = 0; k < 16; ++k) { const size_t row = (size_t)g * S5ROWS + b * 64 + k0 + k; er[k] = xend[row * 128 + p]; ei[k] = xend[row * 128 + 64 + p]; }
#pragma unroll
            for (int k = 0; k < 16; ++k) { const size_t row = (size_t)g * S5ROWS + b * 64 + k0 + k;
                xprev[row * 256 + p] = f2bf(xr); xprev[row * 256 + 64 + p] = f2bf(xi); xprev[row * 256 + 128 + p] = 0; xprev[row * 256 + 192 + p] = 0;
                const float nr = ar * xr - ai * xi + er[k], ni = ar * xi + ai * xr + ei[k]; xr = nr; xi = ni; } }
    }
}

__device__ __forceinline__ void phase_mixnorm(const Params& P, int l) {
    OPQ_IDS
    unsigned char* ws = P.ws; asm volatile("" : "+s"(ws)); const int lane = TID_ & 63, wv = TID_ >> 6;
    bf16_t* ycat = (bf16_t*)(ws + WS.ycat); const bf16_t* oc = (const bf16_t*)(ws + WS.oc); const bf16_t* os = (const bf16_t*)(ws + WS.os); const bf16_t* ow = (const bf16_t*)(ws + WS.ow);
    const float* g = in_ptr(23) + (size_t)l * DM;
    for (int r = BID_ * 8 + wv; r < T_; r += NBLK_ * 8) {
#pragma unroll
        for (int grp = 0; grp < 4; ++grp) { float v[8];
            const u32x4 a = *(const u32x4*)(ycat + (size_t)r * DM + grp * 512 + lane * 8);
            v[0] = bflo(a.x); v[1] = bfhi(a.x); v[2] = bflo(a.y); v[3] = bfhi(a.y); v[4] = bflo(a.z); v[5] = bfhi(a.z); v[6] = bflo(a.w); v[7] = bfhi(a.w);
            if (grp == 1) { const u32x4 b = *(const u32x4*)(oc + (size_t)r * 512 + lane * 8), c = *(const u32x4*)(os + (size_t)r * 512 + lane * 8), d = *(const u32x4*)(ow + (size_t)r * 512 + lane * 8);
                v[0] = bflo(b.x) + bflo(c.x) + bflo(d.x); v[1] = bfhi(b.x) + bfhi(c.x) + bfhi(d.x); v[2] = bflo(b.y) + bflo(c.y) + bflo(d.y); v[3] = bfhi(b.y) + bfhi(c.y) + bfhi(d.y);
                v[4] = bflo(b.z) + bflo(c.z) + bflo(d.z); v[5] = bfhi(b.z) + bfhi(c.z) + bfhi(d.z); v[6] = bflo(b.w) + bflo(c.w) + bflo(d.w); v[7] = bfhi(b.w) + bfhi(c.w) + bfhi(d.w); }
            float ss = 0.f;
#pragma unroll
            for (int j = 0; j < 8; ++j) ss += v[j] * v[j];
            ss = wave_sum(ss); const float rs = rsqrtf(ss * (1.f / 512.f) + 1e-6f);
            const f32x4 g0 = *(const f32x4*)(g + grp * 512 + lane * 8), g1 = *(const f32x4*)(g + grp * 512 + lane * 8 + 4);
            u32x4 w; w.x = cvt_pk_bf16(v[0] * rs * g0[0], v[1] * rs * g0[1]); w.y = cvt_pk_bf16(v[2] * rs * g0[2], v[3] * rs * g0[3]);
            w.z = cvt_pk_bf16(v[4] * rs * g1[0], v[5] * rs * g1[1]); w.w = cvt_pk_bf16(v[6] * rs * g1[2], v[7] * rs * g1[3]);
            *(u32x4*)(ycat + (size_t)r * DM + grp * 512 + lane * 8) = w; }
    }
}

__device__ __forceinline__ void phase_route(const Params& P, int l) {
    OPQ_IDS
    unsigned char* ws = P.ws; asm volatile("" : "+s"(ws)); const float* lg = (const float*)(ws + WS.logits); unsigned* cnt = (unsigned*)(ws + WS.ctl) + CW_CNT + l * 64;
    int* mlist = (int*)(ws + WS.mlist); float* mwt = (float*)(ws + WS.mwt); int* mtok = (int*)(ws + WS.mtok);
    const float* bg = in_ptr(27) + (size_t)l * 4; const float* be = in_ptr(29) + (size_t)l * 32;
    for (int t = BID_ * 512 + TID_; t < T_; t += NBLK_ * 512) {
        const float* r = lg + (size_t)t * 256;
        float gl[4]; float gm = -1e30f; int gi = 0;
#pragma unroll
        for (int i = 0; i < 4; ++i) { gl[i] = r[i] + bg[i]; if (gl[i] > gm) { gm = gl[i]; gi = i; } }
        float gs = 0.f;
#pragma unroll
        for (int i = 0; i < 4; ++i) gs += __expf(gl[i] - gm);
        const float ptop = 1.f / gs;
        float el[8]; float em = -1e30f;
#pragma unroll
        for (int i = 0; i < 8; ++i) { el[i] = r[4 + gi * 8 + i] + be[gi * 8 + i]; em = fmaxf(em, el[i]); }
        float es = 0.f;
#pragma unroll
        for (int i = 0; i < 8; ++i) { el[i] = __expf(el[i] - em); es += el[i]; }
        float p1 = -1.f, p2 = -1.f; int i1 = 0, i2 = 0;
#pragma unroll
        for (int i = 0; i < 8; ++i) { const float p = el[i]; if (p > p1) { p2 = p1; i2 = i1; p1 = p; i1 = i; } else if (p > p2) { p2 = p; i2 = i; } }
        const float inv = 1.f / (p1 + p2); const float w1 = ptop * p1 * inv, w2 = ptop * p2 * inv;
        const int e1 = gi * 8 + i1, e2 = gi * 8 + i2;
        const int s1 = (int)atomicAdd(&cnt[e1], 1u), s2 = (int)atomicAdd(&cnt[e2], 1u);
        mlist[(size_t)e1 * T_ + s1] = t; mwt[(size_t)e1 * T_ + s1] = w1; mlist[(size_t)e2 * T_ + s2] = t; mwt[(size_t)e2 * T_ + s2] = w2;
        mtok[t * 4 + 0] = e1; mtok[t * 4 + 1] = s1; mtok[t * 4 + 2] = e2; mtok[t * 4 + 3] = s2;
    }
}


__device__ __forceinline__ void phase_moe_gather(const Params& P, const LAS int* tiles, const LAS int* cnt) {
    OPQ_IDS
    unsigned char* ws = P.ws; asm volatile("" : "+s"(ws));
    const int lane = TID_ & 63, wv = TID_ >> 6;
    const int* mlist = (const int*)(ws + WS.mlist); const bf16_t* h = (const bf16_t*)(ws + WS.h); bf16_t* xg = (bf16_t*)(ws + WS_XG);
    const int total = tiles[32] * 256;
    for (int r = BID_ * 8 + wv; r < total; r += NBLK_ * 8) {
        const int tile = r >> 8; int e = 0;
#pragma unroll 1
        while (e < 31 && tile >= tiles[e + 1]) ++e;
        const int slot = r - tiles[e] * 256;
        if (slot < cnt[e]) { const int t = mlist[(size_t)e * T_ + slot];
#pragma unroll
            for (int i = 0; i < 4; ++i) *(u32x4*)(xg + (size_t)r * DM + (i * 64 + lane) * 8) = *(const u32x4*)(h + (size_t)t * DM + (i * 64 + lane) * 8); }
    }
}

__device__ __forceinline__ void phase_combine(const Params& P, int l, const LAS int* tiles, const float* g, bool final_) {
    OPQ_IDS
    unsigned char* ws = P.ws; asm volatile("" : "+s"(ws)); const int lane = TID_ & 63, wv = TID_ >> 6;
    const bf16_t* yd = (const bf16_t*)(ws + WS.yd); const int* mtok = (const int*)(ws + WS.mtok); bf16_t* h = (bf16_t*)(ws + WS.h); float* x = P.out;
    for (int r = BID_ * 8 + wv; r < T_; r += NBLK_ * 8) {
        const int e1 = mtok[r * 4 + 0], s1 = mtok[r * 4 + 1], e2 = mtok[r * 4 + 2], s2 = mtok[r * 4 + 3];
        const size_t c1 = (size_t)tiles[e1] * 256 + s1, c2 = (size_t)tiles[e2] * 256 + s2;
        float v[32]; float ss = 0.f;
#pragma unroll
        for (int i = 0; i < 4; ++i) { const int c = (i * 64 + lane) * 8; const f32x4 x0 = *(const f32x4*)(x + (size_t)r * DM + c), x1 = *(const f32x4*)(x + (size_t)r * DM + c + 4);
            const u32x4 a = *(const u32x4*)(yd + c1 * DM + c), b = *(const u32x4*)(yd + c2 * DM + c);
            v[i * 8 + 0] = x0[0] + bflo(a.x) + bflo(b.x); v[i * 8 + 1] = x0[1] + bfhi(a.x) + bfhi(b.x); v[i * 8 + 2] = x0[2] + bflo(a.y) + bflo(b.y); v[i * 8 + 3] = x0[3] + bfhi(a.y) + bfhi(b.y);
            v[i * 8 + 4] = x1[0] + bflo(a.z) + bflo(b.z); v[i * 8 + 5] = x1[1] + bfhi(a.z) + bfhi(b.z); v[i * 8 + 6] = x1[2] + bflo(a.w) + bflo(b.w); v[i * 8 + 7] = x1[3] + bfhi(a.w) + bfhi(b.w);
#pragma unroll
            for (int j = 0; j < 8; ++j) ss += v[i * 8 + j] * v[i * 8 + j]; }
        ss = wave_sum(ss); const float rs = rsqrtf(ss * (1.f / DM) + 1e-6f);
#pragma unroll
        for (int i = 0; i < 4; ++i) { const int c = (i * 64 + lane) * 8; const f32x4 g0 = *(const f32x4*)(g + c), g1 = *(const f32x4*)(g + c + 4);
            if (final_) { f32x4 o0, o1;
#pragma unroll
                for (int j = 0; j < 4; ++j) { o0[j] = v[i * 8 + j] * rs * g0[j]; o1[j] = v[i * 8 + 4 + j] * rs * g1[j]; }
                *(f32x4*)(x + (size_t)r * DM + c) = o0; *(f32x4*)(x + (size_t)r * DM + c + 4) = o1; }
            else { f32x4 o0, o1;
#pragma unroll
                for (int j = 0; j < 4; ++j) { o0[j] = v[i * 8 + j]; o1[j] = v[i * 8 + 4 + j]; }
                *(f32x4*)(x + (size_t)r * DM + c) = o0; *(f32x4*)(x + (size_t)r * DM + c + 4) = o1;
                u32x4 w; w.x = cvt_pk_bf16(v[i * 8 + 0] * rs * g0[0], v[i * 8 + 1] * rs * g0[1]); w.y = cvt_pk_bf16(v[i * 8 + 2] * rs * g0[2], v[i * 8 + 3] * rs * g0[3]);
                w.z = cvt_pk_bf16(v[i * 8 + 4] * rs * g1[0], v[i * 8 + 5] * rs * g1[1]); w.w = cvt_pk_bf16(v[i * 8 + 6] * rs * g1[2], v[i * 8 + 7] * rs * g1[3]);
                *(u32x4*)(h + (size_t)r * DM + c) = w; } }
    }
}

namespace at {
constexpr int SHM_K = 16384, SHM_V = 16384;
constexpr int OFF_V = 0, OFF_K = 32768, OFF_WS = 65536  , OFF_SEL = 65536 + 2048  , OFF_IMP = 69632  ;
constexpr float SCALE = 0.08838834764831845f, C2 = 1.4426950408889634f * SCALE;
#define KSWZ(row, colB) ((row) * 256 + ((colB) ^ (((row) & 7) << 4)))
__device__ __forceinline__ int v_st(int k, int c) { const int kk = (k & ~0xC) | ((k & 4) << 1) | ((k & 8) >> 1); return ((kk >> 3) * 4 + (c >> 5)) * 512 + ((kk & 7) * 32 + (c & 31)) * 2; }
__device__ __forceinline__ int v_rd_base(int lane) { return ((lane & 3) << 3) | (((lane >> 2) & 3) << 6) | (((lane >> 4) & 1) << 5) | (((lane >> 5) & 1) << 8); }
constexpr int v_rd_off(int d0, int ks, int half) { return d0 * 512 + ks * 4096 + half * 2048; }
__device__ __forceinline__ int crow(int r, int hi) { return (r & 3) + 8 * (r >> 2) + 4 * hi; }

__device__ __forceinline__ void qkt(f32x16& p0, f32x16& p1, const LAS char* Kb, int r32, int hi, const bf16x8* qr) {
    p0 = f32x16{}; p1 = f32x16{};
    const LAS char* kb[4];
#pragma unroll
    for (int dd = 0; dd < 4; ++dd) kb[dd] = Kb + KSWZ(r32, (dd * 16 + hi * 8) * 2);
#pragma unroll
    for (int d0 = 0; d0 < 8; ++d0) { const LAS char* a = kb[d0 & 3] + (d0 >> 2) * 128;
        const bf16x8 b0 = *reinterpret_cast<const LAS bf16x8*>(a);
        const bf16x8 b1 = *reinterpret_cast<const LAS bf16x8*>(a + 32 * 256);
        p0 = __builtin_amdgcn_mfma_f32_32x32x16_bf16(b0, qr[d0], p0, 0, 0, 0);
        p1 = __builtin_amdgcn_mfma_f32_32x32x16_bf16(b1, qr[d0], p1, 0, 0, 0); }
}
__device__ __forceinline__ void pv_tile(f32x16* o, int vb0, bf16x8 pa0, bf16x8 pa1, bf16x8 pa2, bf16x8 pa3) {
#define TRRD(dst, off) asm volatile("ds_read_b64_tr_b16 %0, %1 offset:%2" : "=&v"(dst) : "v"(vb0), "i"(off) : "memory")
#define PV_D0(d0) do { s16x4 l0, l1, l2, l3, h0, h1, h2, h3; constexpr int b_ = v_rd_off(d0, 0, 0); \
        TRRD(l0, b_); TRRD(h0, b_ + 2048); TRRD(l1, b_ + 4096); TRRD(h1, b_ + 6144); TRRD(l2, b_ + 8192); TRRD(h2, b_ + 10240); TRRD(l3, b_ + 12288); TRRD(h3, b_ + 14336); \
        asm volatile("s_waitcnt lgkmcnt(0)" ::: "memory"); __builtin_amdgcn_sched_barrier(0); \
        o[d0] = __builtin_amdgcn_mfma_f32_32x32x16_bf16(pa0, (bf16x8){l0[0], l0[1], l0[2], l0[3], h0[0], h0[1], h0[2], h0[3]}, o[d0], 0, 0, 0); \
        o[d0] = __builtin_amdgcn_mfma_f32_32x32x16_bf16(pa1, (bf16x8){l1[0], l1[1], l1[2], l1[3], h1[0], h1[1], h1[2], h1[3]}, o[d0], 0, 0, 0); \
        o[d0] = __builtin_amdgcn_mfma_f32_32x32x16_bf16(pa2, (bf16x8){l2[0], l2[1], l2[2], l2[3], h2[0], h2[1], h2[2], h2[3]}, o[d0], 0, 0, 0); \
        o[d0] = __builtin_amdgcn_mfma_f32_32x32x16_bf16(pa3, (bf16x8){l3[0], l3[1], l3[2], l3[3], h3[0], h3[1], h3[2], h3[3]}, o[d0], 0, 0, 0); } while (0)
    PV_D0(0); PV_D0(1); PV_D0(2); PV_D0(3);
#undef PV_D0
#undef TRRD
}
__device__ __forceinline__ void mask_tile(f32x16& p0, f32x16& p1, int dq, unsigned W) {
    const float NEG = -__builtin_inff();
#pragma unroll
    for (int r = 0; r < 16; ++r) { const int c = (r & 3) + 8 * (r >> 2);
        if ((unsigned)(dq - c) >= W) p0[r] = NEG;
        if ((unsigned)(dq - c - 32) >= W) p1[r] = NEG; }
}
__device__ __forceinline__ float half_swap_max(float v) { auto rr = __builtin_amdgcn_permlane32_swap(__float_as_uint(v), __float_as_uint(v), false, false); return fmaxf(__uint_as_float(rr[0]), __uint_as_float(rr[1])); }
__device__ __forceinline__ float half_swap_sum(float v) { auto rr = __builtin_amdgcn_permlane32_swap(__float_as_uint(v), __float_as_uint(v), false, false); return __uint_as_float(rr[0]) + __uint_as_float(rr[1]); }
__device__ __forceinline__ void pack_p(const f32x16& p0, const f32x16& p1, bf16x8& pa0, bf16x8& pa1, bf16x8& pa2, bf16x8& pa3) {
#define PK4(P, B_, OUT) do { unsigned a0 = cvt_pk_bf16(P[B_+0], P[B_+1]), a1 = cvt_pk_bf16(P[B_+2], P[B_+3]); \
        unsigned b0 = cvt_pk_bf16(P[B_+4], P[B_+5]), b1 = cvt_pk_bf16(P[B_+6], P[B_+7]); \
        auto r0 = __builtin_amdgcn_permlane32_swap(a0, b0, false, false); auto r1 = __builtin_amdgcn_permlane32_swap(a1, b1, false, false); \
        u32x4 w = {r0[0], r1[0], r0[1], r1[1]}; OUT = *reinterpret_cast<bf16x8*>(&w); } while (0)
    PK4(p0, 0, pa0); PK4(p0, 8, pa1); PK4(p1, 0, pa2); PK4(p1, 8, pa3);
#undef PK4
}

struct Job {
    const bf16_t* Q; int ldq;
    const bf16_t* K; int ldk; const bf16_t* Kalt; int ldkalt;
    const bf16_t* V; int ldv;
    bf16_t* O; int ldo;
    const bf16_t* gate; int ldg, gofs;
    const float* rope; int rope_d0;
    int nsa;
    int head;
    int pos0;
};

__device__ __forceinline__ void load_q(bf16x8* qr, const Job& jb, int qpos, int head, int hi) {
    const bf16_t* qp = jb.Q + (size_t)qpos * jb.ldq + head * 128 + hi * 8;
#pragma unroll
    for (int d0 = 0; d0 < 8; ++d0) qr[d0] = *reinterpret_cast<const bf16x8*>(qp + d0 * 16);
    const float* rp = jb.rope + qpos * 32 + hi * 8;
    f32x4 c0 = *(const f32x4*)rp, c1 = *(const f32x4*)(rp + 4), s0 = *(const f32x4*)(rp + 16), s1 = *(const f32x4*)(rp + 20);
    float cs[8] = {c0[0], c0[1], c0[2], c0[3], c1[0], c1[1], c1[2], c1[3]}, sn[8] = {s0[0], s0[1], s0[2], s0[3], s1[0], s1[1], s1[2], s1[3]};
#define ROPE_AT(D) do { bf16x8 a = qr[D], b = qr[D + 1]; \
        _Pragma("unroll") for (int j = 0; j < 8; ++j) { const float x1 = bf2f((bf16_t)a[j]), x2 = bf2f((bf16_t)b[j]); a[j] = (short)f2bf(x1 * cs[j] - x2 * sn[j]); b[j] = (short)f2bf(x2 * cs[j] + x1 * sn[j]); } \
        qr[D] = a; qr[D + 1] = b; } while (0)
    if (jb.rope_d0 == 0) ROPE_AT(0); else ROPE_AT(6);
#undef ROPE_AT
}

struct Stage { bf16x8 k0, k1, v0, v1; };
__device__ __forceinline__ void stage_load(Stage& st, const Job& jb, int kb, int sr, int sch) {
    const size_t r0 = (size_t)(kb + sr), r1 = (size_t)(kb + 32 + sr);
    if (jb.Kalt && sch >= 12) { st.k0 = *reinterpret_cast<const bf16x8*>(jb.Kalt + r0 * jb.ldkalt + (sch - 12) * 8); st.k1 = *reinterpret_cast<const bf16x8*>(jb.Kalt + r1 * jb.ldkalt + (sch - 12) * 8); }
    else { st.k0 = *reinterpret_cast<const bf16x8*>(jb.K + r0 * jb.ldk + sch * 8); st.k1 = *reinterpret_cast<const bf16x8*>(jb.K + r1 * jb.ldk + sch * 8); }
    st.v0 = *reinterpret_cast<const bf16x8*>(jb.V + r0 * jb.ldv + sch * 8); st.v1 = *reinterpret_cast<const bf16x8*>(jb.V + r1 * jb.ldv + sch * 8);
}
__device__ __forceinline__ void stage_write(const Stage& st, LAS char* lds, int buf, int sr, int sch) {
    LAS char* Kb = lds + OFF_K + buf * SHM_K; LAS char* Vb = lds + OFF_V + buf * SHM_V;
    const int kws = KSWZ(sr, sch * 16);
    *reinterpret_cast<LAS bf16x8*>(Kb + kws) = st.k0; *reinterpret_cast<LAS bf16x8*>(Kb + kws + 32 * 256) = st.k1;
    *reinterpret_cast<LAS bf16x8*>(Vb + v_st(sr, sch * 8)) = st.v0; *reinterpret_cast<LAS bf16x8*>(Vb + v_st(32 + sr, sch * 8)) = st.v1;
}

__device__ __forceinline__ void store_o(const f32x16* o, float l_reg, const Job& jb, LAS float* wsf, int qpos0w, int head, int r32, int hi) {
    float sc = l_reg > 0.f ? 1.f / l_reg : 0.f;
    if (jb.gate) sc *= sigmoidf_(bf2f(jb.gate[(size_t)(qpos0w + r32) * jb.ldg + jb.gofs + 3 * head]));
    if (hi == 0) wsf[r32] = sc;
    asm volatile("s_waitcnt lgkmcnt(0)" ::: "memory");
    bf16_t* Ow = jb.O + (size_t)qpos0w * jb.ldo + head * 128;
#pragma unroll
    for (int r = 0; r < 16; ++r) { const int orow = crow(r, hi); const float s = wsf[orow];
#pragma unroll
        for (int d0 = 0; d0 < 4; ++d0) { const float v = o[d0][r] * s; const float vn = __shfl_xor(v, 1);
            if ((r32 & 1) == 0) *(unsigned*)(Ow + (size_t)orow * jb.ldo + d0 * 32 + r32) = cvt_pk_bf16(v, vn); } }
}

__device__ __forceinline__ void flash(const Job& jb, LAS char* lds, unsigned tiles, unsigned W, bool use_sel) {
    int tid = threadIdx.x; asm volatile("" : "+v"(tid));
    const int wid = __builtin_amdgcn_readfirstlane(tid >> 6), lane = tid & 63, r32 = lane & 31, hi = lane >> 5;
    const int head = jb.nsa ? (wid & 3) : jb.head; const int qpos0w = jb.pos0 + 32 * (jb.nsa ? (wid >> 2) : wid); const int qpos = qpos0w + r32;
    LAS float* wsf = (LAS float*)(lds + OFF_WS) + wid * 64;
    bf16x8 qr[8]; load_q(qr, jb, qpos, head, hi);
    const unsigned rowsel = use_sel ? ((const LAS unsigned*)(lds + OFF_SEL))[qpos - jb.pos0] : 0xffffffffu;
    const int sr = tid >> 4, sch = tid & 15;
    const int vb00 = (int)(uintptr_t)(lds + OFF_V) + v_rd_base(lane);
    float m_reg = -1e30f, l_reg = 0.f; f32x16 o[4] = {};
    Stage st;
    unsigned rem = tiles; int j = __builtin_ctz(rem); rem &= rem - 1; int buf = 0;
    stage_load(st, jb, j * 64, sr, sch);
    __syncthreads();
    stage_write(st, lds, 0, sr, sch);
    __syncthreads();
    for (;;) {
        const bool has_next = rem != 0u; int jn = 0;
        if (has_next) { jn = __builtin_ctz(rem); rem &= rem - 1; stage_load(st, jb, jn * 64, sr, sch); }
        f32x16 p0, p1;
        qkt(p0, p1, lds + OFF_K + buf * SHM_K, r32, hi, qr);
        const int kb = j * 64;
        { const bool rowok = (rowsel >> j) & 1u; const unsigned We = rowok ? W : 0u;
          const bool need = (kb + 63 > qpos0w) || ((long)kb <= (long)qpos0w + 31 - (long)W) || use_sel;
          if (need) mask_tile(p0, p1, qpos - kb - 4 * hi, We); }
        float pmax = p0[0];
#pragma unroll
        for (int r = 1; r < 16; ++r) pmax = fmaxf(pmax, p0[r]);
#pragma unroll
        for (int r = 0; r < 16; ++r) pmax = fmaxf(pmax, p1[r]);
        pmax = half_swap_max(pmax);
        const float mn = fmaxf(m_reg, pmax); const float alpha = __builtin_amdgcn_exp2f((m_reg - mn) * C2); m_reg = mn;
        const float mnL = -mn * C2; float ps = 0.f;
#pragma unroll
        for (int r = 0; r < 16; ++r) { p0[r] = __builtin_amdgcn_exp2f(fmaf(p0[r], C2, mnL)); ps += p0[r]; }
#pragma unroll
        for (int r = 0; r < 16; ++r) { p1[r] = __builtin_amdgcn_exp2f(fmaf(p1[r], C2, mnL)); ps += p1[r]; }
        ps = half_swap_sum(ps); l_reg = l_reg * alpha + ps;
        if (__any(alpha < 1.f)) { if (hi == 0) wsf[32 + r32] = alpha; asm volatile("s_waitcnt lgkmcnt(0)" ::: "memory");
#pragma unroll
            for (int r = 0; r < 16; ++r) { const float a = wsf[32 + crow(r, hi)];
#pragma unroll
                for (int d = 0; d < 4; ++d) o[d][r] *= a; } }
        bf16x8 pa0, pa1, pa2, pa3; pack_p(p0, p1, pa0, pa1, pa2, pa3);
        pv_tile(o, vb00 + buf * SHM_V, pa0, pa1, pa2, pa3);
        if (!has_next) break;
        stage_write(st, lds, buf ^ 1, sr, sch);
        __syncthreads();
        buf ^= 1; j = jn;
    }
    store_o(o, l_reg, jb, wsf, qpos0w, head, r32, hi);
}

__device__ __forceinline__ unsigned cmp_select(const Job& jb, LAS char* lds) {
    int tid = threadIdx.x; asm volatile("" : "+v"(tid));
    const int wid = __builtin_amdgcn_readfirstlane(tid >> 6), lane = tid & 63, r32 = lane & 31, hi = lane >> 5;
    const int head = wid & 3; const int qpos0w = jb.pos0 + 32 * (wid >> 2); const int qpos = qpos0w + r32;
    LAS float* wsf = (LAS float*)(lds + OFF_WS) + wid * 64;
    bf16x8 qr[8]; load_q(qr, jb, qpos, head, hi);
    const int sr = tid >> 4, sch = tid & 15;
    const int vb00 = (int)(uintptr_t)(lds + OFF_V) + v_rd_base(lane);
    Stage s0, s1; stage_load(s0, jb, 0, sr, sch); stage_load(s1, jb, 64, sr, sch);
    __syncthreads();
    stage_write(s0, lds, 0, sr, sch); stage_write(s1, lds, 1, sr, sch);
    __syncthreads();
    f32x16 a0, a1, b0, b1;
    qkt(a0, a1, lds + OFF_K, r32, hi, qr); qkt(b0, b1, lds + OFF_K + SHM_K, r32, hi, qr);
    const int nmax = qpos >= 31 ? ((qpos - 31) >> 4) : -1;
    mask_tile(a0, a1, nmax - 4 * hi, 0x7fffffffu); mask_tile(b0, b1, nmax - 64 - 4 * hi, 0x7fffffffu);
    float pmax = -__builtin_inff();
#pragma unroll
    for (int r = 0; r < 16; ++r) pmax = fmaxf(fmaxf(pmax, a0[r]), fmaxf(a1[r], fmaxf(b0[r], b1[r])));
    pmax = half_swap_max(pmax); if (pmax < -1e37f) pmax = 0.f;
    const float mnL = -pmax * C2; float ps = 0.f;
#pragma unroll
    for (int r = 0; r < 16; ++r) { a0[r] = __builtin_amdgcn_exp2f(fmaf(a0[r], C2, mnL)); a1[r] = __builtin_amdgcn_exp2f(fmaf(a1[r], C2, mnL)); b0[r] = __builtin_amdgcn_exp2f(fmaf(b0[r], C2, mnL)); b1[r] = __builtin_amdgcn_exp2f(fmaf(b1[r], C2, mnL));
        ps += (a0[r] + a1[r]) + (b0[r] + b1[r]); }
    ps = half_swap_sum(ps); const float inv = ps > 0.f ? 1.f / ps : 0.f;
#pragma unroll
    for (int r = 0; r < 16; ++r) { a0[r] *= inv; a1[r] *= inv; b0[r] *= inv; b1[r] *= inv; }
    LAS float* imp = (LAS float*)(lds + OFF_IMP) + (wid * 32 + r32) * 32;
#define GRP(P, gq, i) do { const float s_ = (P[4 * gq] + P[4 * gq + 1]) + (P[4 * gq + 2] + P[4 * gq + 3]); const float pc = __shfl_xor(P[4 * gq + 3], 32); \
        imp[2 * (i) + hi] = s_ + (hi ? pc : pcp); pcp = pc; } while (0)
    { float pcp = 0.f;
      GRP(a0, 0, 0); GRP(a0, 1, 1); GRP(a0, 2, 2); GRP(a0, 3, 3); GRP(a1, 0, 4); GRP(a1, 1, 5); GRP(a1, 2, 6); GRP(a1, 3, 7);
      GRP(b0, 0, 8); GRP(b0, 1, 9); GRP(b0, 2, 10); GRP(b0, 3, 11); GRP(b1, 0, 12); GRP(b1, 1, 13); GRP(b1, 2, 14); GRP(b1, 3, 15); }
#undef GRP
    f32x16 o[4] = {};
    { bf16x8 pa0, pa1, pa2, pa3; pack_p(a0, a1, pa0, pa1, pa2, pa3); pv_tile(o, vb00, pa0, pa1, pa2, pa3);
      pack_p(b0, b1, pa0, pa1, pa2, pa3); pv_tile(o, vb00 + SHM_V, pa0, pa1, pa2, pa3); }
    store_o(o, 1.f, jb, wsf, qpos0w, head, r32, hi);
    __syncthreads();
    unsigned uni = 0u;
    if (tid < 64) { const int q = tid; const int cur = jb.pos0 >> 6;
        LAS float* sc = (LAS float*)(lds + OFF_IMP) + 256 * 32 + q * 33;
        const LAS float* ib = (const LAS float*)(lds + OFF_IMP) + (((q >> 5) * 4) * 32 + (q & 31)) * 32;
        for (int k = 0; k < 32; ++k) { const float v = ib[k] + ib[32 * 32 + k] + ib[2 * 32 * 32 + k] + ib[3 * 32 * 32 + k];
            const bool forced = (k == 0) || (k <= cur && k > cur - 2); sc[k] = forced ? 1e4f : (k <= cur ? v : -1.f); }
        unsigned m = 0u;
        for (int it = 0; it < 8; ++it) { float best = -__builtin_inff(); int bi = 0; for (int k = 0; k < 32; ++k) { const float v = sc[k]; if (v > best) { best = v; bi = k; } } m |= 1u << bi; sc[bi] = -__builtin_inff(); }
        const unsigned valid = cur >= 31 ? 0xffffffffu : ((1u << (cur + 1)) - 1u); m &= valid;
        ((LAS unsigned*)(lds + OFF_SEL))[q] = m;
        unsigned u = m; for (int ofs = 32; ofs > 0; ofs >>= 1) u |= (unsigned)__shfl_xor((int)u, ofs);
        if (q == 0) ((LAS unsigned*)(lds + OFF_SEL))[64] = u; }
    __syncthreads();
    uni = ((const LAS unsigned*)(lds + OFF_SEL))[64];
    return (unsigned)__builtin_amdgcn_readfirstlane((int)uni);
}
}

struct AClass { int type, idx, cost, n; };
struct AOrder { AClass c[72]; };
constexpr AOrder make_aorder() {
    AOrder o{}; int n = 0;
    for (int q = 0; q < 8; ++q) o.c[n++] = AClass{0, q, 4 * (q + 1), 32};
    for (int c = 0; c < 32; ++c) o.c[n++] = AClass{1, c, (c + 1 < 9 ? c + 1 : 9), 8};
    for (int c = 0; c < 32; ++c) o.c[n++] = AClass{2, c, 4 + c, 8};
    for (int i = 1; i < 72; ++i) { AClass k = o.c[i]; int j = i - 1; while (j >= 0 && o.c[j].cost < k.cost) { o.c[j + 1] = o.c[j]; --j; } o.c[j + 1] = k; }
    return o;
}
__device__ const AOrder g_aorder = make_aorder();
constexpr int N_AITEMS = 8 * 32 + 32 * 8 + 32 * 8;

constexpr int LDS_MISC = 131072;
constexpr int LM_BAR = LDS_MISC, LM_Q = LDS_MISC + 16, LM_TILES = LDS_MISC + 320  , LM_CNT = LDS_MISC + 512  , LM_DESC = LDS_MISC + 768;
constexpr int LM_UREC = LDS_MISC + 768 + DEPTH_ * 16 * 160;
constexpr int LDS_BYTES = LM_UREC + 16 * 64;
static_assert(sizeof(g8::GDesc) <= 160, "desc size");

__device__ __forceinline__ void moe_prefix(const Params& P, int l, LAS unsigned char* lds) {
    OPQ_IDS
    __syncthreads();
    if (TID_ == 0) { unsigned* cnt = (unsigned*)(P.ws + WS.ctl) + CW_CNT + l * 64; LAS int* tiles = (LAS int*)(lds + LM_TILES); LAS int* lc = (LAS int*)(lds + LM_CNT); int acc = 0;
        for (int e = 0; e < 32; ++e) { const int c = (int)__hip_atomic_load(cnt + e, __ATOMIC_RELAXED, __HIP_MEMORY_SCOPE_AGENT); lc[e] = c; tiles[e] = acc; acc += (c + 255) >> 8; } tiles[32] = acc; }
    __syncthreads();
}

__device__ __forceinline__ void build_descs(const Params& P, int l, LAS unsigned char* lds) {
    OPQ_IDS
    __syncthreads();
    if (TID_ == 0) {
        unsigned char* ws = P.ws; asm volatile("" : "+s"(ws));
        LAS g8::GDesc* tab = (LAS g8::GDesc*)(lds + LM_DESC + l * 16 * 160); asm volatile("" : "+v"(tab));
        auto mk = [&](int i, const void* A, long long ags, int lda, const void* B, long long bgs, int ldb, int K, int nM, int nN, int nG, int epi, int perm, void* C, long long cgs, int ldc, int coff) {
            LAS g8::GDesc& d = tab[i]; d.A = (const bf16_t*)A; d.B = (const bf16_t*)B; d.a_gs = ags; d.b_gs = bgs; d.lda = lda; d.ldb = ldb; d.K = K; d.nM = nM; d.nN = nN; d.nG = nG; d.epi = epi; d.perm = perm;
            d.C = C; d.c_gs = cgs; d.ldc = ldc; d.coff = coff; d.nvalid = 1 << 30; d.moe = 0; d.v0 = nullptr; d.v1 = nullptr; d.aux = nullptr; d.aux_gs = 0; d.aux_ld = 0; d.X = nullptr; };
        mk(0, ws + WS.h, 0, DM, ws + WS.win, 0, DM, DM, 64, 12, 1, g8::E_BF16, 1, ws + WS.cols, 0, NINP, 0);
        mk(1, ws + WS.cqn, 0, 512, ws + WS.wuq, 0, 512, 512, 64, 2, 1, g8::E_BF16, 1, ws + WS.mq, 0, 512, 0);
        mk(2, ws + WS.ckvn, 0, 256, ws + WS.wukv, 0, 256, 256, 64, 4, 1, g8::E_BF16, 1, ws + WS.mkv, 0, 1024, 0);
        mk(3, ws + WS.kcc, 0, 2048, ws + WS.wcmp1, 0, 2048, 2048, 4, 1, 1, g8::E_F32, 0, ws + WS.zk, 0, 256, 0);
        mk(4, ws + WS.vcc, 0, 2048, (bf16_t*)(ws + WS.wcmp1) + (size_t)256 * 2048, 0, 2048, 2048, 4, 1, 1, g8::E_F32, 0, ws + WS.zv, 0, 256, 0);
        mk(5, ws + WS.pd, 0, 512, ws + WS.wpool, 0, 512, 512, 64, 2, 1, g8::E_POOL, 1, ws + WS.ycat, 0, DM, 1024);
        tab[5].v0 = in_ptr(11) + (size_t)l * 512; tab[5].v1 = in_ptr(12) + (size_t)l * 512;
        mk(6, ws + WS.ud, (long long)S5ROWS * 512, 512, ws + WS.s5t, 512 * 512, 512, 512, 2, 2, 32, g8::E_BF16, 1, ws + WS.yintra, (long long)S5ROWS * 512, 512, 0);
        mk(7, ws + WS.ud, (long long)S5ROWS * 512, 512, ws + WS.s5w, 256 * 512, 512, 512, 2, 1, 32, g8::E_F32, 0, ws + WS.xend, (long long)S5ROWS * 128, 128, 0); tab[7].nvalid = 128;
        mk(8, ws + WS.xprev, (long long)S5ROWS * 256, 256, ws + WS.s5v, 512 * 256, 256, 256, 2, 2, 32, g8::E_S5OUT, 1, ws + WS.yg, 0, 512, 0);
        tab[8].aux = (const bf16_t*)(ws + WS.yintra); tab[8].aux_gs = (long long)S5ROWS * 512; tab[8].aux_ld = 512;
        mk(9, ws + WS.yg, 0, 512, ws + WS.wglu, 0, 512, 512, 64, 2, 1, g8::E_GLU, 1, ws + WS.ycat, 0, DM, 1536);
        tab[9].v0 = in_ptr(22) + (size_t)l * 512; tab[9].aux = (const bf16_t*)(ws + WS.yg); tab[9].aux_ld = 512;
        mk(10, ws + WS.ycat, 0, DM, ws + WS.wout, 0, DM, DM, 64, 8, 1, g8::E_RESID, 0, P.out, 0, DM, 0); tab[10].X = l == 0 ? in_ptr(0) : P.out;
        mk(11, ws + WS.h, 0, DM, ws + WS.wrt, 0, DM, DM, 64, 1, 1, g8::E_F32, 0, ws + WS.logits, 0, 256, 0);
        mk(12, ws + WS_XG, 0, DM, ws + WS.wgu, (long long)1024 * DM, DM, DM, 0, 4, 32, g8::E_SWIGLU, 0, ws + WS.hmid, 0, MOE_H, 0); tab[12].moe = 1;
        mk(13, ws + WS.hmid, 0, MOE_H, ws + WS.wdn, (long long)DM * MOE_H, MOE_H, MOE_H, 0, 8, 32, g8::E_DOWN, 1, ws + WS.yd, 0, DM, 0); tab[13].moe = 2;
    }
    __syncthreads();
}

__device__ __forceinline__ void run_gemms(const Params& P, LAS unsigned char* lds, int l, int d_lo, int d_hi) {
    LAS unsigned char* lm = lds; asm volatile("" : "+v"(lm));
    g8::UnitSrc S; S.tab = (const LAS g8::GDesc*)(lm + LM_DESC + l * 16 * 160); S.d_lo = d_lo; S.d_hi = d_hi; S.G = gridDim.x; S.c = blockIdx.x; S.moe_tiles = (const LAS int*)(lm + LM_TILES); S.rec = (LAS g8::URec*)(lm + LM_UREC);
    unsigned char* ws = P.ws; asm volatile("" : "+s"(ws));
    g8::MoeCtx mc; mc.cnt = (const LAS int*)(lm + LM_CNT); mc.mlist = (const int*)(ws + WS.mlist); mc.mwt = (const float*)(ws + WS.mwt);
    __syncthreads();
    S.build(mc);
    __syncthreads();
    g8::gemm_run(lds, S, mc);
    __syncthreads();
}

__device__ __forceinline__ void phase_attention(const Params& P, int l, LAS unsigned char* ldsu, LAS unsigned char* ldsv, int rep) {
    OPQ_IDS
    unsigned char* ws = P.ws; asm volatile("" : "+s"(ws)); LAS char* lds = (LAS char*)ldsu;
    unsigned* qhead = (unsigned*)(ws + WS.ctl) + CW_QUEUE + l * 64 + rep * 16;
    const bf16_t* cols = (const bf16_t*)(ws + WS.cols);
    for (;;) {
        __syncthreads();
        if (TID_ == 0) *(LAS unsigned*)(ldsv + LM_Q) = atomicAdd(qhead, 1u);
        __syncthreads();
        const int item = __builtin_amdgcn_readfirstlane((int)*(const LAS unsigned*)(ldsv + LM_Q));
        if (item >= N_AITEMS) break;
        int rem = item, ci = 0; while (rem >= g_aorder.c[ci].n) { rem -= g_aorder.c[ci].n; ++ci; }
        const int type = g_aorder.c[ci].type, idx = g_aorder.c[ci].idx;
        at::Job jb{}; jb.rope = (const float*)(ws + WS.rope);
        unsigned tiles = 1u, W = 0x7fffffffu; bool use_sel = false;
        if (type == 0) { const int b = rem >> 2, h = rem & 3; const size_t t0 = (size_t)b * S_;
            jb.Q = (const bf16_t*)(ws + WS.mq) + t0 * 512; jb.ldq = 512;
            jb.K = (const bf16_t*)(ws + WS.mkv) + t0 * 1024 + h * 128; jb.ldk = 1024; jb.Kalt = (const bf16_t*)(ws + WS.krope) + t0 * 32; jb.ldkalt = 32;
            jb.V = (const bf16_t*)(ws + WS.mkv) + t0 * 1024 + 512 + h * 128; jb.ldv = 1024;
            jb.O = (bf16_t*)(ws + WS.ycat) + t0 * DM; jb.ldo = DM; jb.gate = nullptr; jb.rope_d0 = 6; jb.nsa = 0; jb.head = h; jb.pos0 = idx * 256;
            const int nt = 4 * (idx + 1); tiles = nt >= 32 ? 0xffffffffu : ((1u << nt) - 1u);
        } else { const int b = rem; const size_t t0 = (size_t)b * S_; const int c = idx;
            jb.Q = cols + t0 * NINP + C_Q; jb.ldq = NINP; jb.Kalt = nullptr; jb.ldkalt = 0; jb.rope_d0 = 0; jb.nsa = 1; jb.head = 0; jb.pos0 = c * 64;
            jb.gate = cols + t0 * NINP + C_GL; jb.ldg = NINP; jb.ldo = 512;
            if (type == 1) {
                jb.K = cols + t0 * NINP + C_KW; jb.ldk = NINP; jb.V = cols + t0 * NINP + C_VW; jb.ldv = NINP; jb.O = (bf16_t*)(ws + WS.ow) + t0 * 512; jb.gofs = 2;
                const int jlo = c - 8 > 0 ? c - 8 : 0; tiles = (c >= 31 ? 0xffffffffu : ((1u << (c + 1)) - 1u)) & ~((1u << jlo) - 1u); W = 512u;
            } else {
                jb.K = (const bf16_t*)(ws + WS.kcmp) + (size_t)b * 128 * 128; jb.ldk = 128; jb.V = (const bf16_t*)(ws + WS.vcmp) + (size_t)b * 128 * 128; jb.ldv = 128;
                jb.O = (bf16_t*)(ws + WS.oc) + t0 * 512; jb.gofs = 0;
                tiles = at::cmp_select(jb, lds); use_sel = true;
                jb.K = cols + t0 * NINP + C_KS; jb.ldk = NINP; jb.V = cols + t0 * NINP + C_VS; jb.ldv = NINP; jb.O = (bf16_t*)(ws + WS.os) + t0 * 512; jb.gofs = 1;
            }
        }
        at::flash(jb, lds, tiles, W, use_sel);
    }
}

constexpr int PH_PER_LAYER = 16, PH_FINAL_BIT = 16;
template <unsigned MASK>
__global__ void __launch_bounds__(512, 2) fwd_kernel(Params P) {
    LAS unsigned char* lds = (LAS unsigned char*)smem;
    if (threadIdx.x < 4) ((LAS unsigned*)(lds + LM_BAR))[threadIdx.x] = 0u;
    if (threadIdx.x == 0) { LAS unsigned* d = (LAS unsigned*)(lds + LM_INP_OFF); unsigned long long a;
        a = (unsigned long long)P.in[0]; d[0] = (unsigned)a; d[1] = (unsigned)(a >> 32);
        a = (unsigned long long)P.in[1]; d[2] = (unsigned)a; d[3] = (unsigned)(a >> 32);
        a = (unsigned long long)P.in[2]; d[4] = (unsigned)a; d[5] = (unsigned)(a >> 32);
        a = (unsigned long long)P.in[3]; d[6] = (unsigned)a; d[7] = (unsigned)(a >> 32);
        a = (unsigned long long)P.in[4]; d[8] = (unsigned)a; d[9] = (unsigned)(a >> 32);
        a = (unsigned long long)P.in[5]; d[10] = (unsigned)a; d[11] = (unsigned)(a >> 32);
        a = (unsigned long long)P.in[6]; d[12] = (unsigned)a; d[13] = (unsigned)(a >> 32);
        a = (unsigned long long)P.in[7]; d[14] = (unsigned)a; d[15] = (unsigned)(a >> 32);
        a = (unsigned long long)P.in[8]; d[16] = (unsigned)a; d[17] = (unsigned)(a >> 32);
        a = (unsigned long long)P.in[9]; d[18] = (unsigned)a; d[19] = (unsigned)(a >> 32);
        a = (unsigned long long)P.in[10]; d[20] = (unsigned)a; d[21] = (unsigned)(a >> 32);
        a = (unsigned long long)P.in[11]; d[22] = (unsigned)a; d[23] = (unsigned)(a >> 32);
        a = (unsigned long long)P.in[12]; d[24] = (unsigned)a; d[25] = (unsigned)(a >> 32);
        a = (unsigned long long)P.in[13]; d[26] = (unsigned)a; d[27] = (unsigned)(a >> 32);
        a = (unsigned long long)P.in[14]; d[28] = (unsigned)a; d[29] = (unsigned)(a >> 32);
        a = (unsigned long long)P.in[15]; d[30] = (unsigned)a; d[31] = (unsigned)(a >> 32);
        a = (unsigned long long)P.in[16]; d[32] = (unsigned)a; d[33] = (unsigned)(a >> 32);
        a = (unsigned long long)P.in[17]; d[34] = (unsigned)a; d[35] = (unsigned)(a >> 32);
        a = (unsigned long long)P.in[18]; d[36] = (unsigned)a; d[37] = (unsigned)(a >> 32);
        a = (unsigned long long)P.in[19]; d[38] = (unsigned)a; d[39] = (unsigned)(a >> 32);
        a = (unsigned long long)P.in[20]; d[40] = (unsigned)a; d[41] = (unsigned)(a >> 32);
        a = (unsigned long long)P.in[21]; d[42] = (unsigned)a; d[43] = (unsigned)(a >> 32);
        a = (unsigned long long)P.in[22]; d[44] = (unsigned)a; d[45] = (unsigned)(a >> 32);
        a = (unsigned long long)P.in[23]; d[46] = (unsigned)a; d[47] = (unsigned)(a >> 32);
        a = (unsigned long long)P.in[24]; d[48] = (unsigned)a; d[49] = (unsigned)(a >> 32);
        a = (unsigned long long)P.in[25]; d[50] = (unsigned)a; d[51] = (unsigned)(a >> 32);
        a = (unsigned long long)P.in[26]; d[52] = (unsigned)a; d[53] = (unsigned)(a >> 32);
        a = (unsigned long long)P.in[27]; d[54] = (unsigned)a; d[55] = (unsigned)(a >> 32);
        a = (unsigned long long)P.in[28]; d[56] = (unsigned)a; d[57] = (unsigned)(a >> 32);
        a = (unsigned long long)P.in[29]; d[58] = (unsigned)a; d[59] = (unsigned)(a >> 32);
        a = (unsigned long long)P.in[30]; d[60] = (unsigned)a; d[61] = (unsigned)(a >> 32);
        a = (unsigned long long)P.in[31]; d[62] = (unsigned)a; d[63] = (unsigned)(a >> 32);
        a = (unsigned long long)P.in[32]; d[64] = (unsigned)a; d[65] = (unsigned)(a >> 32);
        a = (unsigned long long)P.in[33]; d[66] = (unsigned)a; d[67] = (unsigned)(a >> 32);
    }
    __syncthreads();
    XcdBarrier bar = xcd_barrier_post((unsigned*)(P.ws + WS.ctl) + CW_BAR, (volatile LAS unsigned*)(lds + LM_BAR));
    unsigned char* ws = P.ws; asm volatile("" : "+s"(ws));
    constexpr bool MULTI = (MASK & (MASK - 1)) != 0;
#define PHASE(p) if constexpr ((MASK >> (p)) & 1u)
#define SEAM() do { if constexpr (MULTI) xcd_barrier(bar); } while (0)
    if constexpr (MULTI) xcd_barrier_census(bar);
    for (int l = P.ph_lo; l < P.ph_hi; ++l) build_descs(P, l, lds);
    for (int l = P.ph_lo; l < P.ph_hi; ++l) {
        LAS unsigned char* ldsv = lds;
        PHASE(0) {
            if (l == 0) phase_rmsnorm(in_ptr(0), in_ptr(1), (bf16_t*)(ws + WS.h));
            else { moe_prefix(P, l - 1, ldsv); phase_combine(P, l - 1, (const LAS int*)(ldsv + LM_TILES), in_ptr(1) + (size_t)l * DM, false); }
            phase_convert(P, l, lds);
            phase_precompute(P, l, lds);
            SEAM();
            if constexpr (REP_MASK & 1u) { phase_convert(P, l, lds); phase_precompute(P, l, lds); SEAM(); } }
        PHASE(1) { run_gemms(P, lds, l, 0, 1); SEAM(); if constexpr ((REP_MASK >> 1) & 1u) { run_gemms(P, lds, l, 0, 1); SEAM(); } }
        PHASE(2) { phase_post_inproj(P, l); phase_s5_toeplitz(P); SEAM(); if constexpr ((REP_MASK >> 2) & 1u) { phase_post_inproj(P, l); phase_s5_toeplitz(P); SEAM(); } }
        PHASE(3) { run_gemms(P, lds, l, 1, 8); SEAM(); if constexpr ((REP_MASK >> 3) & 1u) { run_gemms(P, lds, l, 1, 8); SEAM(); } }
        PHASE(4) { phase_cmp_finish(P, l, (LAS float*)lds); phase_s5_scan(P, l); SEAM(); if constexpr ((REP_MASK >> 4) & 1u) { phase_cmp_finish(P, l, (LAS float*)lds); phase_s5_scan(P, l); SEAM(); } }
        PHASE(5) { run_gemms(P, lds, l, 8, 9); SEAM(); if constexpr ((REP_MASK >> 5) & 1u) { run_gemms(P, lds, l, 8, 9); SEAM(); } }
        PHASE(6) { phase_attention(P, l, lds, ldsv, 0); SEAM(); if constexpr ((REP_MASK >> 6) & 1u) { phase_attention(P, l, lds, ldsv, 1); SEAM(); } }
        PHASE(7) { run_gemms(P, lds, l, 9, 10); SEAM(); if constexpr ((REP_MASK >> 7) & 1u) { run_gemms(P, lds, l, 9, 10); SEAM(); } }
        PHASE(8) { phase_mixnorm(P, l); SEAM(); if constexpr ((REP_MASK >> 8) & 1u) { phase_mixnorm(P, l); SEAM(); } }
        PHASE(9) { run_gemms(P, lds, l, 10, 11); SEAM(); if constexpr ((REP_MASK >> 9) & 1u) { run_gemms(P, lds, l, 10, 11); SEAM(); } }
        PHASE(10) { phase_rmsnorm(P.out, in_ptr(25) + (size_t)l * DM, (bf16_t*)(ws + WS.h)); SEAM(); if constexpr ((REP_MASK >> 10) & 1u) { phase_rmsnorm(P.out, in_ptr(25) + (size_t)l * DM, (bf16_t*)(ws + WS.h)); SEAM(); } }
        PHASE(11) { run_gemms(P, lds, l, 11, 12); SEAM(); if constexpr ((REP_MASK >> 11) & 1u) { run_gemms(P, lds, l, 11, 12); SEAM(); } }
        PHASE(12) { phase_route(P, l); SEAM(); if constexpr ((REP_MASK >> 12) & 1u) { phase_route(P, l); SEAM(); } }
        PHASE(13) { moe_prefix(P, l, ldsv); phase_moe_gather(P, (const LAS int*)(ldsv + LM_TILES), (const LAS int*)(ldsv + LM_CNT)); SEAM(); if constexpr ((REP_MASK >> 13) & 1u) { moe_prefix(P, l, ldsv); phase_moe_gather(P, (const LAS int*)(ldsv + LM_TILES), (const LAS int*)(ldsv + LM_CNT)); SEAM(); } }
        PHASE(14) { moe_prefix(P, l, ldsv); run_gemms(P, lds, l, 12, 13); SEAM(); if constexpr ((REP_MASK >> 14) & 1u) { moe_prefix(P, l, ldsv); run_gemms(P, lds, l, 12, 13); SEAM(); } }
        PHASE(15) { moe_prefix(P, l, ldsv); run_gemms(P, lds, l, 13, 14); SEAM(); if constexpr ((REP_MASK >> 15) & 1u) { moe_prefix(P, l, ldsv); run_gemms(P, lds, l, 13, 14); SEAM(); } }
    }
    PHASE(PH_FINAL_BIT) { if (P.ph_hi == DEPTH_) { LAS unsigned char* ldsv = lds; moe_prefix(P, DEPTH_ - 1, ldsv); phase_combine(P, DEPTH_ - 1, (const LAS int*)(ldsv + LM_TILES), in_ptr(33), true); } }
#undef PHASE
#undef SEAM
}

template <unsigned MASK> static void launch_mask(const Params& p, int grid, hipStream_t stream) {
    static bool attr = false;
    if (!attr) { (void)hipFuncSetAttribute((const void*)fwd_kernel<MASK>, hipFuncAttributeMaxDynamicSharedMemorySize, LDS_BYTES); attr = true; }
    hipLaunchKernelGGL(fwd_kernel<MASK>, dim3(grid), dim3(512), LDS_BYTES, stream, p);
}

extern "C" void kernel_launch(void* const* d_in, const int* in_sizes, int n_in, void* d_out, int out_size, void* d_ws, size_t ws_size, hipStream_t stream) {
    static int grid = 0;
    if (grid == 0) {
        if (n_in != 34 || out_size != T_ * DM || ws_size < WS.end) { fprintf(stderr, "kernel_launch: unexpected shapes (n_in %d out %d ws %zu need %zu)\n", n_in, out_size, ws_size, (size_t)WS.end); grid = -1; return; }
        int dev = 0, cus = 0;
        if (hipGetDevice(&dev) != hipSuccess || hipDeviceGetAttribute(&cus, hipDeviceAttributeMultiprocessorCount, dev) != hipSuccess) { grid = -1; return; }
        grid = cus;
    }
    if (grid < 0) return;
    (void)hipMemsetAsync((char*)d_ws + WS.ctl, 0, CTL_BYTES, stream);
    Params p; memset(&p, 0, sizeof(p));
    for (int i = 0; i < 34; ++i) p.in[i] = (const float*)d_in[i];
    p.out = (float*)d_out; p.ws = (unsigned char*)d_ws;
#if N_LAUNCH_SPLIT
    for (int l = 0; l < DEPTH_; ++l) { p.ph_lo = l; p.ph_hi = l + 1;
        launch_mask<1u << 0>(p, grid, stream); launch_mask<1u << 1>(p, grid, stream); launch_mask<1u << 2>(p, grid, stream); launch_mask<1u << 3>(p, grid, stream);
        launch_mask<1u << 4>(p, grid, stream); launch_mask<1u << 5>(p, grid, stream); launch_mask<1u << 6>(p, grid, stream); launch_mask<1u << 7>(p, grid, stream);
        launch_mask<1u << 8>(p, grid, stream); launch_mask<1u << 9>(p, grid, stream); launch_mask<1u << 10>(p, grid, stream); launch_mask<1u << 11>(p, grid, stream);
        launch_mask<1u << 12>(p, grid, stream); launch_mask<1u << 13>(p, grid, stream); launch_mask<1u << 14>(p, grid, stream); launch_mask<1u << 15>(p, grid, stream); }
    p.ph_lo = DEPTH_; p.ph_hi = DEPTH_; launch_mask<1u << 16>(p, grid, stream);
#else
    p.ph_lo = 0; p.ph_hi = DEPTH_; launch_mask<0x1ffffu>(p, grid, stream);
#endif
}
```

```cpp
#include <hip/hip_runtime.h>
#include <stdint.h>
#include <stdio.h>
#include <string.h>

#ifndef REP_MASK
#define REP_MASK 0u
#endif
#ifndef N_LAUNCH_SPLIT
#define N_LAUNCH_SPLIT 0
#endif

#define LAS __attribute__((address_space(3)))
typedef unsigned short bf16_t;
typedef short bf16x8 __attribute__((ext_vector_type(8)));
typedef short s16x4 __attribute__((ext_vector_type(4)));
typedef float f32x4 __attribute__((ext_vector_type(4)));
typedef float f32x16 __attribute__((ext_vector_type(16)));
typedef unsigned u32x4 __attribute__((ext_vector_type(4)));
typedef unsigned u32x2 __attribute__((ext_vector_type(2)));

constexpr int T_ = 16384, S_ = 2048, NB_ = 8, DM = 2048, DEPTH_ = 2;
constexpr int NIN = 2924, NINP = 3072;
constexpr int C_CQ = 0, C_CKV = 448, C_KROPE = 576, C_Q = 608, C_KC = 1120, C_VC = 1248, C_KS = 1376, C_VS = 1504, C_KW = 1632, C_VW = 1760,
              C_CC = 1888, C_CD = 2400, C_GL = 2912;
constexpr int NEXP = 32, MOE_H = 512;
constexpr int MOE_ROWS = 32768 + 32 * 256;
constexpr int S5L = 32, S5ROWS = T_ / S5L;

#define OPQ_IDS int TID_ = threadIdx.x; asm volatile("" : "+v"(TID_)); int BID_ = blockIdx.x; asm volatile("" : "+s"(BID_)); int NBLK_ = gridDim.x; asm volatile("" : "+s"(NBLK_));
__device__ __forceinline__ unsigned cvt_pk_bf16(float lo, float hi) { unsigned r; asm volatile("v_cvt_pk_bf16_f32 %0, %1, %2" : "=v"(r) : "v"(lo), "v"(hi)); return r; }
__device__ __forceinline__ bf16_t f2bf(float f) { return (bf16_t)(cvt_pk_bf16(f, 0.f) & 0xffffu); }
__device__ __forceinline__ float bf2f(bf16_t b) { return __uint_as_float(((unsigned)b) << 16); }
__device__ __forceinline__ float bflo(unsigned w) { return __uint_as_float(w << 16); }
__device__ __forceinline__ float bfhi(unsigned w) { return __uint_as_float(w & 0xffff0000u); }
__device__ __forceinline__ float gelu_tanh(float x) { const float u = 0.7978845608028654f * (x + 0.044715f * x * x * x); const float e = __expf(2.f * u); const float th = 1.f - 2.f / (e + 1.f); return 0.5f * x * (1.f + th); }
__device__ __forceinline__ float sigmoidf_(float x) { return 1.f / (1.f + __expf(-x)); }
__device__ __forceinline__ void sincos_r(float ang, float* s, float* c) { const double rev = (double)ang * 0.15915494309189535; const float fr = (float)(rev - floor(rev)); *s = __builtin_amdgcn_sinf(fr); *c = __builtin_amdgcn_cosf(fr); }
__device__ __forceinline__ float wave_sum(float v) { for (int o = 32; o > 0; o >>= 1) v += __shfl_xor(v, o); return v; }

#define XB_TMO      128
#define XB_XCNT(j)  (256  + 64 * (j))
#define XB_XSUB(j)  (1280 + 64 * (j))
#define XB_XGEN(j)  (2304 + 64 * (j))
#define XB_TOP      3328
#define XB_TOPGEN   3392
#define XCD_BAR_WORDS 3456
#define XB_SPIN_CAP (1u << 22)
__device__ __forceinline__ unsigned xb_ld(unsigned* p)              { return __hip_atomic_load(p, __ATOMIC_RELAXED, __HIP_MEMORY_SCOPE_AGENT); }
__device__ __forceinline__ unsigned xb_add(unsigned* p, unsigned v) { return __hip_atomic_fetch_add(p, v, __ATOMIC_RELAXED, __HIP_MEMORY_SCOPE_AGENT); }
__device__ __forceinline__ unsigned xb_xcc_id() { return (unsigned)__builtin_amdgcn_s_getreg((3 << 11) | 20) & 0xFu; }
#define XB_SPIN(cond, bar) do { unsigned _sp = 0; while (cond) { __builtin_amdgcn_s_sleep(1); \
    if ((++_sp & 255u) == 0u) { if (xb_ld(&(bar)[XB_TMO])) break; if (_sp > XB_SPIN_CAP) { atomicAdd(&(bar)[XB_TMO], 1u); break; } } } } while (0)
struct XcdBarrier { unsigned* bar; unsigned x; volatile LAS unsigned* st; };
__device__ __forceinline__ XcdBarrier xcd_barrier_post(unsigned* bar, volatile LAS unsigned* st) {
    XcdBarrier b; b.bar = bar; b.x = xb_xcc_id(); b.st = st;
    if (threadIdx.x == 0) (void)xb_add(&bar[XB_XCNT(b.x)], 1u);
    return b;
}
__device__ __forceinline__ void xcd_barrier_complete(unsigned* bar, unsigned x, unsigned& nloc, unsigned& nx) {
    const unsigned G = gridDim.x * gridDim.y * gridDim.z;
    unsigned sum, cnt, mine, sp = 0u;
    for (;;) {
        sum = 0u; cnt = 0u; mine = 0u;
#pragma unroll
        for (unsigned j = 0; j < 16; ++j) { const unsigned c = xb_ld(&bar[XB_XCNT(j)]); sum += c; cnt += (c > 0u) ? 1u : 0u; mine = (j == x) ? c : mine; }
        if (sum == G) break;
        __builtin_amdgcn_s_sleep(1);
        if ((++sp & 255u) == 0u) { if (xb_ld(&bar[XB_TMO])) break; if (sp > XB_SPIN_CAP) { atomicAdd(&bar[XB_TMO], 1u); break; } }
    }
    nloc = mine > 0u ? mine : 1u; nx = cnt > 0u ? cnt : 1u;
}
__device__ __forceinline__ void xcd_barrier_census(const XcdBarrier& b) {
    if (threadIdx.x == 0) { unsigned nloc, nx; xcd_barrier_complete(b.bar, b.x, nloc, nx); b.st[0] = nloc; b.st[1] = nx; }
    __syncthreads();
}
__device__ __forceinline__ void xcd_barrier(const XcdBarrier& b) {
    asm volatile("s_waitcnt vmcnt(0)" ::: "memory");
    __syncthreads();
    if (threadIdx.x == 0) {
        unsigned* bar = b.bar;
        __builtin_amdgcn_s_waitcnt(0);
        const unsigned nloc = b.st[0], nx = b.st[1];
        const unsigned old = xb_add(&bar[XB_XSUB(b.x)], 1u);
        const unsigned gen = old / nloc;
        if (old + 1u == (gen + 1u) * nloc) {
            __builtin_amdgcn_fence(__ATOMIC_RELEASE, "agent");
            asm volatile("s_waitcnt vmcnt(0)" ::: "memory");
            const unsigned og = xb_add(&bar[XB_TOP], 1u);
            const unsigned tg = og / nx;
            if (og + 1u == (tg + 1u) * nx) xb_add(&bar[XB_TOPGEN], 1u);
            else XB_SPIN(xb_ld(&bar[XB_TOPGEN]) == tg, bar);
            __builtin_amdgcn_fence(__ATOMIC_ACQUIRE, "agent");
            xb_add(&bar[XB_XGEN(b.x)], 1u);
            asm volatile("s_waitcnt vmcnt(0)" ::: "memory");
        } else {
            XB_SPIN(xb_ld(&bar[XB_XGEN(b.x)]) == gen, bar);
            __builtin_amdgcn_fence(__ATOMIC_ACQUIRE, "agent");
            asm volatile("s_waitcnt vmcnt(0)" ::: "memory");
        }
    }
    __syncthreads();
}

constexpr size_t al256(size_t x) { return (x + 255) & ~(size_t)255; }
struct WsMap {
    size_t ctl, win, wuq, wukv, wcmp1, wpool, wglu, wout, wrt, wgu, wdn, s5t, s5w, s5v, s5pow, cmpb1, rope,
           h, cols, cqn, ckvn, krope, pd, ud, kcc, vcc, mq, mkv, zk, zv, kcmp, vcmp, yintra, xend, xprev, yg, ycat, oc, os, ow,
           logits, mlist, mwt, mtok, hmid, yd, end;
};
constexpr size_t CTL_BYTES = 65536;
constexpr int CW_BAR = 0;
constexpr int CW_CNT = 4096;
constexpr int CW_QUEUE = 8192;
constexpr WsMap make_ws() {
    WsMap w{}; size_t o = 0;
    w.ctl = o; o += CTL_BYTES;
    w.win = o;   o += al256((size_t)NINP * DM * 2);
    w.wuq = o;   o += al256((size_t)512 * 512 * 2);
    w.wukv = o;  o += al256((size_t)1024 * 256 * 2);
    w.wcmp1 = o; o += al256((size_t)2 * 256 * 2048 * 2);
    w.wpool = o; o += al256((size_t)512 * 512 * 2);
    w.wglu = o;  o += al256((size_t)512 * 512 * 2);
    w.wout = o;  o += al256((size_t)DM * DM * 2);
    w.wrt = o;   o += al256((size_t)256 * DM * 2);
    w.wgu = o;   o += al256((size_t)NEXP * 1024 * DM * 2);
    w.wdn = o;   o += al256((size_t)NEXP * DM * MOE_H * 2);
    w.s5t = o;   o += al256((size_t)32 * 512 * 512 * 2);
    w.s5w = o;   o += al256((size_t)32 * 256 * 512 * 2);
    w.s5v = o;   o += al256((size_t)32 * 512 * 256 * 2);
    w.s5pow = o; o += al256((size_t)32 * 32 * 256 * 4);
    w.cmpb1 = o; o += al256((size_t)2 * 128 * 4);
    w.rope = o;  o += al256((size_t)S_ * 32 * 4);
    w.h = o;     o += al256((size_t)T_ * DM * 2);
    w.cols = o;  o += al256((size_t)T_ * NINP * 2);
    w.cqn = o;   o += al256((size_t)T_ * 512 * 2);
    w.ckvn = o;  o += al256((size_t)T_ * 256 * 2);
    w.krope = o; o += al256((size_t)T_ * 32 * 2);
    w.pd = o;    o += al256((size_t)T_ * 512 * 2);
    w.ud = o;    o += al256((size_t)T_ * 512 * 2);
    w.kcc = o;   o += al256((size_t)T_ * 128 * 2);
    w.vcc = o;   o += al256((size_t)T_ * 128 * 2);
    w.mq = o;    o += al256((size_t)T_ * 512 * 2);
    w.mkv = o;   o += al256((size_t)T_ * 1024 * 2);
    w.zk = o;    o += al256((size_t)4 * 1024 * 256 * 4);
    w.zv = o;    o += al256((size_t)4 * 1024 * 256 * 4);
    w.kcmp = o;  o += al256((size_t)NB_ * 128 * 128 * 2);
    w.vcmp = o;  o += al256((size_t)NB_ * 128 * 128 * 2);
    w.yintra = o; o += al256((size_t)T_ * 512 * 2);
    w.xend = o;  o += al256((size_t)32 * S5ROWS * 128 * 4);
    w.xprev = o; o += al256((size_t)32 * S5ROWS * 256 * 2);
    w.yg = o;    o += al256((size_t)T_ * 512 * 2);
    w.ycat = o;  o += al256((size_t)T_ * DM * 2);
    w.oc = o;    o += al256((size_t)T_ * 512 * 2);
    w.os = o;    o += al256((size_t)T_ * 512 * 2);
    w.ow = o;    o += al256((size_t)T_ * 512 * 2);
    w.logits = o; o += al256((size_t)4 * T_ * 64 * 4);
    w.mlist = o; o += al256((size_t)NEXP * T_ * 4);
    w.mwt = o;   o += al256((size_t)NEXP * T_ * 4);
    w.mtok = o;  o += al256((size_t)T_ * 4 * 4);
    w.hmid = o;  o += al256((size_t)MOE_ROWS * MOE_H * 2);
    w.yd = o;    o += al256((size_t)MOE_ROWS * DM * 2);
    w.end = o;
    return w;
}
constexpr WsMap WS = make_ws();
constexpr size_t WS_XG = WS.cols;
static_assert(WS.zk - WS.cols >= (size_t)MOE_ROWS * DM * 2, "Xg alias");

extern __shared__ __attribute__((aligned(16))) unsigned char smem[];
constexpr int LM_INP_OFF = 131072 + 32;
__device__ __forceinline__ const float* in_ptr(int i) {
    const LAS unsigned* s = (const LAS unsigned*)((LAS unsigned char*)smem + LM_INP_OFF) + 2 * i;
    const unsigned lo = (unsigned)__builtin_amdgcn_readfirstlane((int)s[0]), hi = (unsigned)__builtin_amdgcn_readfirstlane((int)s[1]);
    return (const float*)(((unsigned long long)hi << 32) | lo);
}
struct Params {
    const float* in[34];
    float* out;
    unsigned char* ws;
    int ph_lo, ph_hi;
};

namespace g8 {
constexpr int BM = 256, BK = 64, HALF = 128, HTB = HALF * BK * 2, STAGE_BYTES = 8 * HTB, NXCD = 8, WGM = 8;
__host__ __device__ __forceinline__ int lds_byte(int r, int c) { const int st = (r >> 4) * 2 + (c >> 5), rr = r & 15, cc = c & 31, ob = rr * 64 + cc * 2; return st * 1024 + (ob ^ (((ob >> 9) & 1) << 5)); }
__host__ __device__ __forceinline__ void stage_rc(int b, int& R, int& C) { const int st = b / 1024, sb = b % 1024, swz = sb ^ (((sb >> 9) & 1) << 5); R = (st >> 1) * 16 + swz / 64; C = (st & 1) * 32 + (swz % 64) / 2; }
__host__ __device__ __forceinline__ int perm32(int rho) { const int n = rho >> 4, i = rho & 15; return 8 * (i >> 2) + 4 * n + (i & 3); }

enum { E_BF16 = 0, E_F32 = 1, E_POOL = 2, E_GLU = 3, E_S5OUT = 4, E_RESID = 5, E_SWIGLU = 6, E_DOWN = 7 };

struct GDesc {
    const bf16_t* A; const bf16_t* B;
    long long a_gs, b_gs;
    int lda, ldb, K;
    int nM, nN, nG;
    int epi, perm;
    void* C; long long c_gs; int ldc, coff, nvalid;
    const float* v0; const float* v1;
    const bf16_t* aux; long long aux_gs; int aux_ld;
    const float* X;
    int moe;
};
struct MoeCtx { const LAS int* cnt; const int* mlist; const float* mwt; };
__device__ __forceinline__ int rfl(int v) { return __builtin_amdgcn_readfirstlane(v); }
template <class P> __device__ __forceinline__ P* rflp(P* p) { const unsigned long long a = (unsigned long long)p; const unsigned lo = (unsigned)__builtin_amdgcn_readfirstlane((int)(unsigned)a), hi = (unsigned)__builtin_amdgcn_readfirstlane((int)(unsigned)(a >> 32)); return (P*)(((unsigned long long)hi << 32) | lo); }

struct UnitRef {
    const char* A; const char* B; unsigned lda2, ldb2; int nt;
    int d, grp, pm, pn, perm; int rowbase;
};

constexpr int MAXU = 16;
struct URec { unsigned a_lo, a_hi, b_lo, b_hi, lda2, ldb2, nt, g_lo, g_hi, gcnt, d, grp, pm, pn, perm_valid, rowbase; };
struct UnitSrc {
    const LAS GDesc* tab; int d_lo, d_hi; int G, c;
    const LAS int* moe_tiles;
    LAS URec* rec;
    __device__ __forceinline__ int desc_units(int d) const { const LAS GDesc& g = tab[d]; if (g.moe) return moe_tiles[32] * g.nN; return g.nG * g.nM * g.nN; }
    __device__ __forceinline__ void build(const MoeCtx& mc) const {
        const int i = threadIdx.x;
        if (i < MAXU) {
            URec r{}; r.perm_valid = 0;
            long L = (long)i * G + c; int d = d_lo;
            for (; d < d_hi; ++d) { const int n = desc_units(d); if (L < n) break; L -= n; }
            if (d < d_hi) {
                const LAS GDesc& g = tab[d];
                const int moe = g.moe, nN = g.nN, nM = g.nM; const bf16_t* gA = g.A; const bf16_t* gB = g.B; const long long a_gs = g.a_gs, b_gs = g.b_gs;
                const unsigned lda2 = (unsigned)g.lda * 2u, ldb2 = (unsigned)g.ldb * 2u;
                const char* A; const char* B; int rowbase = 0, grp, pm, pn;
                if (moe) {
                    const int tile = (int)(L / nN); pn = (int)(L % nN);
                    int e = 0;
#pragma unroll 1
                    while (e < 31 && tile >= moe_tiles[e + 1]) ++e;
                    const int mt = tile - moe_tiles[e];
                    grp = e; pm = mt; rowbase = tile * 256;
                    B = (const char*)(gB + (size_t)e * b_gs) + (size_t)pn * 256 * ldb2;
                    A = (const char*)gA + (size_t)tile * 256 * lda2;
                } else {
                    const int per = nM * nN; grp = (int)(L / per); int wgid = (int)(L % per);
                    const int nwg = per; { const int q = nwg / NXCD, rr = nwg % NXCD, xcd = wgid % NXCD, off = wgid / NXCD; wgid = (xcd < rr ? xcd * (q + 1) : rr * (q + 1) + (xcd - rr) * q) + off; }
                    const int nig = WGM * nN, gid = wgid / nig, fm = gid * WGM, gsz = (nM - fm) < WGM ? (nM - fm) : WGM;
                    pm = fm + ((wgid % nig) % gsz); pn = (wgid % nig) / gsz;
                    A = (const char*)(gA + (size_t)grp * a_gs) + (size_t)pm * 256 * lda2;
                    B = (const char*)(gB + (size_t)grp * b_gs) + (size_t)pn * 256 * ldb2;
                }
                r.a_lo = (unsigned)(unsigned long long)A; r.a_hi = (unsigned)((unsigned long long)A >> 32); r.b_lo = (unsigned)(unsigned long long)B; r.b_hi = (unsigned)((unsigned long long)B >> 32);
                r.lda2 = lda2; r.ldb2 = ldb2; r.nt = (unsigned)(g.K / BK); r.g_lo = 0; r.g_hi = 0; r.gcnt = 0;
                r.d = (unsigned)d; r.grp = (unsigned)grp; r.pm = (unsigned)pm; r.pn = (unsigned)pn; r.perm_valid = 2u | (unsigned)(g.perm & 1); r.rowbase = (unsigned)rowbase;
            }
            LAS unsigned* dst = (LAS unsigned*)&rec[i];
            dst[0] = r.a_lo; dst[1] = r.a_hi; dst[2] = r.b_lo; dst[3] = r.b_hi; dst[4] = r.lda2; dst[5] = r.ldb2; dst[6] = r.nt; dst[7] = r.g_lo; dst[8] = r.g_hi; dst[9] = r.gcnt;
            dst[10] = r.d; dst[11] = r.grp; dst[12] = r.pm; dst[13] = r.pn; dst[14] = r.perm_valid; dst[15] = r.rowbase;
        }
    }
    __device__ __forceinline__ bool get(int i, UnitRef& u) const {
        if (i >= MAXU) return false;
        const LAS unsigned* s = (const LAS unsigned*)&rec[i];
        const unsigned pv = (unsigned)rfl((int)s[14]);
        if (!(pv & 2u)) return false;
        const unsigned long long a = ((unsigned long long)(unsigned)rfl((int)s[1]) << 32) | (unsigned)rfl((int)s[0]), b = ((unsigned long long)(unsigned)rfl((int)s[3]) << 32) | (unsigned)rfl((int)s[2]);
        u.A = (const char*)a; u.B = (const char*)b; u.lda2 = (unsigned)rfl((int)s[4]); u.ldb2 = (unsigned)rfl((int)s[5]); u.nt = rfl((int)s[6]);
        u.d = rfl((int)s[10]); u.grp = rfl((int)s[11]); u.pm = rfl((int)s[12]); u.pn = rfl((int)s[13]); u.perm = (int)(pv & 1u); u.rowbase = rfl((int)s[15]);
        return true;
    }
};

__device__ __forceinline__ u32x4 pack8(const f32x4& a, const f32x4& b) { u32x4 w; w.x = cvt_pk_bf16(a[0], a[1]); w.y = cvt_pk_bf16(a[2], a[3]); w.z = cvt_pk_bf16(b[0], b[1]); w.w = cvt_pk_bf16(b[2], b[3]); return w; }

__device__ __forceinline__ void epilogue(const f32x4 (&acc)[2][2][4][2], const GDesc g, const UnitRef& u, const MoeCtx& mc, int wr, int wc, int fr, int fq) {
    const int row0 = u.pm * 256 + wr * 64 + fr;
    const int colp = u.pn * 256 + wc * 32 + 8 * fq;
    const int coln = u.pn * 256 + wc * 32 + 4 * fq;
    switch (g.epi) {
    case E_BF16: {
        bf16_t* base = (bf16_t*)g.C + (size_t)u.grp * g.c_gs + g.coff;
#pragma unroll
        for (int ai = 0; ai < 2; ++ai)
#pragma unroll
            for (int m = 0; m < 4; ++m) { bf16_t* rowp = base + (size_t)(row0 + ai * HALF + m * 16) * g.ldc + colp;
#pragma unroll
                for (int bj = 0; bj < 2; ++bj) *(u32x4*)(rowp + bj * HALF) = pack8(acc[ai][bj][m][0], acc[ai][bj][m][1]); }
    } break;
    case E_F32: {
        float* base = (float*)g.C + (size_t)u.grp * g.c_gs + g.coff;
#pragma unroll
        for (int ai = 0; ai < 2; ++ai)
#pragma unroll
            for (int m = 0; m < 4; ++m) { float* rowp = base + (size_t)(row0 + ai * HALF + m * 16) * g.ldc;
#pragma unroll
                for (int bj = 0; bj < 2; ++bj)
#pragma unroll
                    for (int n = 0; n < 2; ++n) { const int c = coln + bj * HALF + n * 16; if (c < g.nvalid) *(f32x4*)(rowp + c) = acc[ai][bj][m][n]; } }
    } break;
    case E_POOL: {
        bf16_t* base = (bf16_t*)g.C + g.coff;
        f32x4 b0[2][2], s0[2][2];
#pragma unroll
        for (int bj = 0; bj < 2; ++bj)
#pragma unroll
            for (int n = 0; n < 2; ++n) { b0[bj][n] = *(const f32x4*)(g.v0 + colp + bj * HALF + 4 * n); s0[bj][n] = *(const f32x4*)(g.v1 + colp + bj * HALF + 4 * n); }
#pragma unroll
        for (int ai = 0; ai < 2; ++ai)
#pragma unroll
            for (int m = 0; m < 4; ++m) { bf16_t* rowp = base + (size_t)(row0 + ai * HALF + m * 16) * g.ldc + colp;
#pragma unroll
                for (int bj = 0; bj < 2; ++bj) { const f32x4 a = (acc[ai][bj][m][0] + b0[bj][0]) * s0[bj][0], b = (acc[ai][bj][m][1] + b0[bj][1]) * s0[bj][1];
                    *(u32x4*)(rowp + bj * HALF) = pack8(a, b); } }
    } break;
    case E_GLU: {
        bf16_t* base = (bf16_t*)g.C + g.coff;
        f32x4 b0[2][2];
#pragma unroll
        for (int bj = 0; bj < 2; ++bj)
#pragma unroll
            for (int n = 0; n < 2; ++n) b0[bj][n] = *(const f32x4*)(g.v0 + colp + bj * HALF + 4 * n);
#pragma unroll
        for (int ai = 0; ai < 2; ++ai)
#pragma unroll
            for (int m = 0; m < 4; ++m) { const size_t r = (size_t)(row0 + ai * HALF + m * 16); bf16_t* rowp = base + r * g.ldc + colp;
#pragma unroll
                for (int bj = 0; bj < 2; ++bj) { const u32x4 y = *(const u32x4*)(g.aux + r * g.aux_ld + colp + bj * HALF);
                    const f32x4 z0 = acc[ai][bj][m][0] + b0[bj][0], z1 = acc[ai][bj][m][1] + b0[bj][1];
                    f32x4 a, b;
                    a[0] = bflo(y.x) * sigmoidf_(z0[0]); a[1] = bfhi(y.x) * sigmoidf_(z0[1]); a[2] = bflo(y.y) * sigmoidf_(z0[2]); a[3] = bfhi(y.y) * sigmoidf_(z0[3]);
                    b[0] = bflo(y.z) * sigmoidf_(z1[0]); b[1] = bfhi(y.z) * sigmoidf_(z1[1]); b[2] = bflo(y.w) * sigmoidf_(z1[2]); b[3] = bfhi(y.w) * sigmoidf_(z1[3]);
                    *(u32x4*)(rowp + bj * HALF) = pack8(a, b); } }
    } break;
    case E_S5OUT: {
        bf16_t* yg = (bf16_t*)g.C; const bf16_t* yin = g.aux + (size_t)u.grp * g.aux_gs;
#pragma unroll
        for (int ai = 0; ai < 2; ++ai)
#pragma unroll
            for (int m = 0; m < 4; ++m) { const size_t r = (size_t)(row0 + ai * HALF + m * 16);
#pragma unroll
                for (int bj = 0; bj < 2; ++bj) { const int c = colp + bj * HALF; const u32x4 y = *(const u32x4*)(yin + r * g.aux_ld + c);
                    const f32x4 z0 = acc[ai][bj][m][0], z1 = acc[ai][bj][m][1];
                    f32x4 a, b;
                    a[0] = gelu_tanh(z0[0] + bflo(y.x)); a[1] = gelu_tanh(z0[1] + bfhi(y.x)); a[2] = gelu_tanh(z0[2] + bflo(y.y)); a[3] = gelu_tanh(z0[3] + bfhi(y.y));
                    b[0] = gelu_tanh(z1[0] + bflo(y.z)); b[1] = gelu_tanh(z1[1] + bfhi(y.z)); b[2] = gelu_tanh(z1[2] + bflo(y.w)); b[3] = gelu_tanh(z1[3] + bfhi(y.w));
                    const int t = c >> 4, ch = c & 15;
                    *(u32x4*)(yg + (r * 32 + t) * 512 + 16 * u.grp + ch) = pack8(a, b); } }
    } break;
    case E_RESID: {
        float* base = (float*)g.C; const float* xin = g.X;
#pragma unroll
        for (int ai = 0; ai < 2; ++ai)
#pragma unroll
            for (int m = 0; m < 4; ++m) { const size_t ro = (size_t)(row0 + ai * HALF + m * 16) * g.ldc;
#pragma unroll
                for (int bj = 0; bj < 2; ++bj)
#pragma unroll
                    for (int n = 0; n < 2; ++n) { const int c = coln + bj * HALF + n * 16; *(f32x4*)(base + ro + c) = *(const f32x4*)(xin + ro + c) + acc[ai][bj][m][n]; } }
    } break;
    case E_SWIGLU: {
        bf16_t* hm = (bf16_t*)g.C; const int e = u.grp; const int cnt = rfl(mc.cnt[e]);
        const int f0 = u.pn * 128 + wc * 16 + 4 * fq;
#pragma unroll
        for (int ai = 0; ai < 2; ++ai)
#pragma unroll
            for (int m = 0; m < 4; ++m) { const int lr = wr * 64 + fr + ai * HALF + m * 16; const int slot = u.pm * 256 + lr;
                const float w = slot < cnt ? mc.mwt[(size_t)e * T_ + slot] : 0.f;
                bf16_t* rowp = hm + (size_t)(u.rowbase + lr) * MOE_H + f0;
#pragma unroll
                for (int bj = 0; bj < 2; ++bj) { const f32x4 gt = acc[ai][bj][m][0], up = acc[ai][bj][m][1]; f32x4 o;
#pragma unroll
                    for (int j = 0; j < 4; ++j) o[j] = slot < cnt ? gt[j] * sigmoidf_(gt[j]) * up[j] * w : 0.f;
                    u32x2 pk; pk.x = cvt_pk_bf16(o[0], o[1]); pk.y = cvt_pk_bf16(o[2], o[3]);
                    *(u32x2*)(rowp + bj * 64) = pk; } }
    } break;
    case E_DOWN: {
        bf16_t* yd = (bf16_t*)g.C;
        const int lr0 = wr * 64 + fr;
#pragma unroll
        for (int ai = 0; ai < 2; ++ai)
#pragma unroll
            for (int m = 0; m < 4; ++m) { bf16_t* rowp = yd + (size_t)(u.rowbase + lr0 + ai * HALF + m * 16) * DM + colp;
#pragma unroll
                for (int bj = 0; bj < 2; ++bj) *(u32x4*)(rowp + bj * HALF) = pack8(acc[ai][bj][m][0], acc[ai][bj][m][1]); }
    } break;
    default: break;
    }
}

__device__ __forceinline__ void gemm_run(LAS unsigned char* lds, const UnitSrc& S, const MoeCtx& mc) {
    int tid = threadIdx.x; asm volatile("" : "+v"(tid));
    const int wid = __builtin_amdgcn_readfirstlane(tid >> 6), lane = tid & 63, wr = wid >> 2, wc = wid & 3, fr = lane & 15, fq = lane >> 4;
    unsigned voffA[2], voffB[2];
    const unsigned ldsw = (unsigned)wid * 1024u;
    const int aoff = lds_byte(wr * 64 + fr, fq * 8), boff = lds_byte(wc * 32 + fr, fq * 8);
#define G8_VOFF(u) do { _Pragma("unroll") for (int _i = 0; _i < 2; ++_i) { int _R, _C; stage_rc(tid * 16 + _i * 8192, _R, _C); \
        const int _Rb = (u).perm ? ((_R & ~31) + perm32(_R & 31)) : _R; voffB[_i] = (unsigned)_Rb * (u).ldb2 + (unsigned)_C * 2u; voffA[_i] = (unsigned)_R * (u).lda2 + (unsigned)_C * 2u; } } while (0)
#define G8_SA(b, h) (((b) * 2 + (h)) * HTB)
#define G8_SB(b, h) ((4 + (b) * 2 + (h)) * HTB)
#define G8_STAGE(bufoff, gbase, voff) do { _Pragma("unroll") for (int _i = 0; _i < 2; ++_i) \
        __builtin_amdgcn_global_load_lds((const unsigned*)((const char*)(gbase) + (voff)[_i]), (LAS unsigned*)(lds + (bufoff) + ldsw + _i * 8192), 16, 0, 0); } while (0)
#define G8_LDA(dst, b, h) do { _Pragma("unroll") for (int m = 0; m < 4; ++m) _Pragma("unroll") for (int k = 0; k < 2; ++k) dst[m][k] = *(const LAS bf16x8*)(lds + G8_SA(b, h) + aoff + m * 2048 + k * 1024); } while (0)
#define G8_LDB(dst, b, h) do { _Pragma("unroll") for (int n = 0; n < 2; ++n) _Pragma("unroll") for (int k = 0; k < 2; ++k) dst[n][k] = *(const LAS bf16x8*)(lds + G8_SB(b, h) + boff + n * 2048 + k * 1024); } while (0)
#define G8_MMA(ai, bj, At, Bt) do { __builtin_amdgcn_s_setprio(1); _Pragma("unroll") for (int m = 0; m < 4; ++m) _Pragma("unroll") for (int n = 0; n < 2; ++n) _Pragma("unroll") for (int k = 0; k < 2; ++k) \
        acc[ai][bj][m][n] = __builtin_amdgcn_mfma_f32_16x16x32_bf16(Bt[n][k], At[m][k], acc[ai][bj][m][n], 0, 0, 0); __builtin_amdgcn_s_setprio(0); } while (0)
#define G8_WAIT_V(n) asm volatile("s_waitcnt vmcnt(" #n ")" ::: "memory")
#define G8_WAIT_L(n) asm volatile("s_waitcnt lgkmcnt(" #n ")" ::: "memory")
#define G8_BAR __builtin_amdgcn_s_barrier()
#define G8_SCHED __builtin_amdgcn_sched_barrier(0)
    UnitRef cur, nxt; int ui = 0;
    if (!S.get(0, cur)) return;
    f32x4 acc[2][2][4][2];
#pragma unroll
    for (int a = 0; a < 2; ++a)
#pragma unroll
        for (int b = 0; b < 2; ++b)
#pragma unroll
            for (int m = 0; m < 4; ++m)
#pragma unroll
                for (int n = 0; n < 2; ++n) acc[a][b][m][n] = (f32x4){0.f, 0.f, 0.f, 0.f};
    bf16x8 At[4][2], B0[2][2], B1[2][2];
    const char* cA = cur.A; const char* cB = cur.B; size_t chB = (size_t)HALF * cur.ldb2, chA = (size_t)HALF * cur.lda2;
    G8_VOFF(cur);
    const size_t kstep = (size_t)(BK * 2);
    G8_STAGE(G8_SB(0, 0), cB, voffB); G8_STAGE(G8_SA(0, 0), cA, voffA); G8_STAGE(G8_SB(0, 1), cB + chB, voffB); G8_STAGE(G8_SA(0, 1), cA + chA, voffA);
    if (wr == 1) G8_BAR;
    G8_WAIT_V(4); G8_BAR;
    G8_STAGE(G8_SB(1, 0), cB + kstep, voffB); G8_STAGE(G8_SA(1, 0), cA + kstep, voffA); G8_STAGE(G8_SB(1, 1), cB + chB + kstep, voffB);
    G8_WAIT_V(6); G8_BAR;
    for (;;) {
        bool has_next = false; const char* nA = cA; const char* nB = cB; size_t nhB = chB, nhA = chA;
        const int nt = cur.nt;
        for (int t = 0; t < nt; t += 2) {
            const bool last = (t == nt - 2);
            if (last) { has_next = S.get(ui + 1, nxt); if (has_next) { nA = nxt.A; nB = nxt.B; nhB = (size_t)HALF * nxt.ldb2; nhA = (size_t)HALF * nxt.lda2; } }
            const char* a1 = cA + (size_t)(t + 1) * kstep;
            const char* a2 = last ? nA : cA + (size_t)(t + 2) * kstep; const char* b2 = last ? nB : cB + (size_t)(t + 2) * kstep;
            const char* a3 = a2 + kstep; const char* b3 = b2 + kstep;
            const size_t hB2 = last ? nhB : chB, hA2 = last ? nhA : chA;
            G8_LDB(B0, 0, 0); G8_SCHED; G8_LDA(At, 0, 0); G8_STAGE(G8_SA(1, 1), a1 + chA, voffA);
            if (last && has_next) { G8_VOFF(nxt); }
            G8_WAIT_L(8); G8_BAR; G8_WAIT_L(0); G8_MMA(0, 0, At, B0); G8_BAR; G8_SCHED;
            G8_LDB(B1, 0, 1); G8_STAGE(G8_SB(0, 0), b2, voffB);
            G8_BAR; G8_WAIT_L(0); G8_MMA(0, 1, At, B1); G8_BAR;
            G8_LDA(At, 0, 1); G8_STAGE(G8_SA(0, 0), a2, voffA);
            G8_BAR; G8_WAIT_L(0); G8_MMA(1, 0, At, B0); G8_BAR; G8_SCHED;
            G8_STAGE(G8_SB(0, 1), b2 + hB2, voffB);
            G8_WAIT_V(6); G8_BAR; G8_MMA(1, 1, At, B1); G8_BAR;
            G8_LDB(B0, 1, 0); G8_SCHED; G8_LDA(At, 1, 0); G8_STAGE(G8_SA(0, 1), a2 + hA2, voffA);
            G8_WAIT_L(8); G8_BAR; G8_WAIT_L(0); G8_MMA(0, 0, At, B0); G8_BAR; G8_SCHED;
            G8_LDB(B1, 1, 1); G8_STAGE(G8_SB(1, 0), b3, voffB);
            G8_BAR; G8_WAIT_L(0); G8_MMA(0, 1, At, B1); G8_BAR;
            G8_LDA(At, 1, 1); G8_STAGE(G8_SA(1, 0), a3, voffA);
            G8_BAR; G8_WAIT_L(0); G8_MMA(1, 0, At, B0); G8_BAR; G8_SCHED;
            G8_STAGE(G8_SB(1, 1), b3 + hB2, voffB);
            G8_WAIT_V(6); G8_BAR; G8_MMA(1, 1, At, B1); G8_BAR;
        }
        { GDesc gd; { const LAS unsigned* sp = (const LAS unsigned*)&S.tab[cur.d]; unsigned* dp = (unsigned*)&gd; _Pragma("unroll") for (int _w = 0; _w < (int)(sizeof(GDesc) / 4); ++_w) dp[_w] = (unsigned)rfl((int)sp[_w]); }
          epilogue(acc, gd, cur, mc, wr, wc, fr, fq); }
        if (!has_next) break;
#pragma unroll
        for (int a = 0; a < 2; ++a)
#pragma unroll
            for (int b = 0; b < 2; ++b)
#pragma unroll
                for (int m = 0; m < 4; ++m)
#pragma unroll
                    for (int n = 0; n < 2; ++n) acc[a][b][m][n] = (f32x4){0.f, 0.f, 0.f, 0.f};
        cur = nxt; cA = nA; cB = nB; chB = nhB; chA = nhA; ++ui;
    }
    G8_WAIT_V(0);
    if (wr == 0) G8_BAR;
    G8_BAR;
#undef G8_VOFF
#undef G8_SA
#undef G8_SB
#undef G8_STAGE
#undef G8_LDA
#undef G8_LDB
#undef G8_MMA
#undef G8_WAIT_V
#undef G8_WAIT_L
#undef G8_BAR
#undef G8_SCHED
}
}

template <class F>
__device__ __forceinline__ void conv_job(const F& f, bf16_t* dst, int N, int K, int ldd, LAS unsigned char* tb0) {
    OPQ_IDS
    const int lane = TID_ & 63, wv = TID_ >> 6;
    LAS unsigned char* tb = tb0 + wv * (64 * 136);
    const int tn = N / 64, tk = K / 64, nt = tn * tk;
    for (int t = BID_ * 8 + wv; t < nt; t += NBLK_ * 8) {
        const int n0 = (t % tn) * 64, k0 = (t / tn) * 64;
        f32x4 va[8], vb[8];
#pragma unroll
        for (int i = 0; i < 8; ++i) { const int idx = lane + i * 64; const int n4 = (idx & 15) * 4, kp = idx >> 4;
            const float* p0 = f(n0 + n4, k0 + 2 * kp); const float* p1 = f(n0 + n4, k0 + 2 * kp + 1);
            va[i] = p0 ? *(const f32x4*)p0 : (f32x4){0.f, 0.f, 0.f, 0.f}; vb[i] = p1 ? *(const f32x4*)p1 : (f32x4){0.f, 0.f, 0.f, 0.f}; }
#pragma unroll
        for (int i = 0; i < 8; ++i) { const int idx = lane + i * 64; const int n4 = (idx & 15) * 4, kp = idx >> 4;
#pragma unroll
            for (int j = 0; j < 4; ++j) *(LAS unsigned*)(tb + (n4 + j) * 136 + kp * 4) = cvt_pk_bf16(va[i][j], vb[i][j]); }
        asm volatile("s_waitcnt lgkmcnt(0)" ::: "memory");
#pragma unroll
        for (int i = 0; i < 8; ++i) { const int idx = lane + i * 64; const int nn = idx >> 3, k8 = idx & 7;
            const u32x2 lo = *(const LAS u32x2*)(tb + nn * 136 + k8 * 16), hi = *(const LAS u32x2*)(tb + nn * 136 + k8 * 16 + 8);
            u32x4 w; w.x = lo.x; w.y = lo.y; w.z = hi.x; w.w = hi.y;
            *(u32x4*)(dst + (size_t)(n0 + nn) * ldd + k0 + k8 * 8) = w; }
        asm volatile("s_waitcnt lgkmcnt(0)" ::: "memory");
    }
}

__device__ __forceinline__ int win_map(int n) { if (n < C_CC) return n; if (n < C_GL) return n + 12; if (n < C_GL + 12) return n - C_GL + 1888; return -1; }

__device__ __forceinline__ void phase_convert(const Params& P, int l, LAS unsigned char* tl) {
    unsigned char* ws = P.ws; asm volatile("" : "+s"(ws));
    { const float* w = in_ptr(2) + (size_t)l * DM * NIN;
      conv_job([=](int n, int k) -> const float* { const int c = win_map(n); return c >= 0 ? w + (size_t)k * NIN + c : nullptr; }, (bf16_t*)(ws + WS.win), NINP, DM, DM, tl); }
    { const float* w = in_ptr(24) + (size_t)l * DM * DM;
      conv_job([=](int n, int k) -> const float* { return w + (size_t)k * DM + n; }, (bf16_t*)(ws + WS.wout), DM, DM, DM, tl); }
    { const float* w = in_ptr(5) + (size_t)l * 448 * 512;
      conv_job([=](int n, int k) -> const float* { return k < 448 ? w + (size_t)k * 512 + n : nullptr; }, (bf16_t*)(ws + WS.wuq), 512, 512, 512, tl); }
    { const float* w = in_ptr(6) + (size_t)l * 128 * 896;
      conv_job([=](int n, int k) -> const float* { int c; if (n < 512) { const int h = n >> 7, j = n & 127; c = j < 96 ? h * 224 + j : -1; } else { const int h = (n - 512) >> 7, j = n & 127; c = h * 224 + 96 + j; }
                                            return (k < 128 && c >= 0) ? w + (size_t)k * 896 + c : nullptr; }, (bf16_t*)(ws + WS.wukv), 1024, 256, 256, tl); }
    for (int kv = 0; kv < 2; ++kv) { const float* w = in_ptr(8) + ((size_t)l * 2 + kv) * 4096 * 128;
      conv_job([=](int n, int k) -> const float* { return n < 128 ? w + (size_t)k * 128 + n : w + (size_t)(2048 + k) * 128 + (n - 128); }, (bf16_t*)(ws + WS.wcmp1) + (size_t)kv * 256 * 2048, 256, 2048, 2048, tl); }
    { const float* w = in_ptr(10) + (size_t)l * 4 * 128 * 128;
      conv_job([=](int n, int k) -> const float* { const int gi = n >> 7; return (k >> 7) == gi ? w + ((size_t)gi * 128 + (k & 127)) * 128 + (n & 127) : nullptr; }, (bf16_t*)(ws + WS.wpool), 512, 512, 512, tl); }
    { const float* w = in_ptr(21) + (size_t)l * 512 * 512;
      conv_job([=](int n, int k) -> const float* { return w + (size_t)k * 512 + n; }, (bf16_t*)(ws + WS.wglu), 512, 512, 512, tl); }
    { const float* wg = in_ptr(26) + (size_t)l * DM * 4; const float* we = in_ptr(28) + (size_t)l * DM * 32;
      conv_job([=](int n, int k) -> const float* { return n < 4 ? wg + (size_t)k * 4 + n : (n < 36 ? we + (size_t)k * 32 + (n - 4) : nullptr); }, (bf16_t*)(ws + WS.wrt), 256, DM, DM, tl); }
    { const float* wg = in_ptr(30) + (size_t)l * NEXP * DM * MOE_H; const float* wu = in_ptr(31) + (size_t)l * NEXP * DM * MOE_H;
      conv_job([=](int n, int k) -> const float* { const int e = n >> 10, nn = n & 1023, f = (nn >> 5) * 16 + (nn & 15); const float* s = (nn & 16) ? wu : wg; return s + ((size_t)e * DM + k) * MOE_H + f; },
               (bf16_t*)(ws + WS.wgu), NEXP * 1024, DM, DM, tl); }
    { const float* wd = in_ptr(32) + (size_t)l * NEXP * MOE_H * DM;
      conv_job([=](int n, int k) -> const float* { const int e = n >> 11, d = n & 2047; return wd + ((size_t)e * MOE_H + k) * DM + d; }, (bf16_t*)(ws + WS.wdn), NEXP * DM, MOE_H, MOE_H, tl); }
}

struct S5P { float lr, li, dt, cr, ci; };
__device__ __forceinline__ S5P s5_param(const Params& P, int l, int g, int p) {
    S5P s; s.lr = in_ptr(13)[((size_t)l * 32 + g) * 64 + p]; s.li = in_ptr(14)[((size_t)l * 32 + g) * 64 + p]; s.dt = __expf(in_ptr(15)[(size_t)l * 32 + g]);
    const float mag = __expf(s.lr * s.dt); float sn, cs; sincos_r(s.li * s.dt, &sn, &cs);
    const float ar = mag * cs, ai = mag * sn, den = s.lr * s.lr + s.li * s.li, nr = ar - 1.f, ni = ai;
    s.cr = (nr * s.lr + ni * s.li) / den; s.ci = (ni * s.lr - nr * s.li) / den; return s;
}
__device__ __forceinline__ void s5_apow(const S5P& s, int d, float& r, float& i) { const float mag = __expf((float)d * s.lr * s.dt); float sn, cs; sincos_r((float)d * (s.li * s.dt), &sn, &cs); r = mag * cs; i = mag * sn; }

__device__ __forceinline__ void phase_precompute(const Params& P, int l, LAS unsigned char* lds) {
    OPQ_IDS
    unsigned char* ws = P.ws; asm volatile("" : "+s"(ws)); const int gtid = BID_ * 512 + TID_, gsz = NBLK_ * 512;
    float* rope = (float*)(ws + WS.rope);
    for (int i = gtid; i < S_ * 16; i += gsz) { const int s = i >> 4, j = i & 15; const float inv = exp2f(-(float)j * (1.f / 16.f) * 18.931568569324174f); const float ang = (float)s * inv; float sn, cs; sincos_r(ang, &sn, &cs); rope[s * 32 + j] = cs; rope[s * 32 + 16 + j] = sn; }
    { const int wv = gtid >> 6, lane = TID_ & 63, nwv = gsz >> 6;
      for (int o = wv; o < 256; o += nwv) { const int kv = o >> 7, j = o & 127; const float* pe = in_ptr(7) + ((size_t)l * 2 + kv) * 4096; const float* w1 = in_ptr(8) + ((size_t)l * 2 + kv) * 4096 * 128;
          float s = 0.f; for (int k = lane; k < 4096; k += 64) s += pe[k] * w1[(size_t)k * 128 + j]; s = wave_sum(s); if (lane == 0) ((float*)(ws + WS.cmpb1))[o] = s; } }
    LAS float* apw = (LAS float*)lds;
    LAS float* bb = apw + 64 * 34 * 2;
    LAS float* cc = bb + 64 * 16 * 2;
    float* km = (float*)(ws + WS.s5pow); bf16_t* wt = (bf16_t*)(ws + WS.s5w); bf16_t* vt = (bf16_t*)(ws + WS.s5v);
    for (int wg = BID_; wg < 32 * 8; wg += NBLK_) { const int g = wg & 31, sub = wg >> 5;
        __syncthreads();
        for (int i = TID_; i < 64 * 34; i += 512) { const int p = i / 34, d = i - p * 34; const S5P s = s5_param(P, l, g, p); float pr, pi; s5_apow(s, d, pr, pi); apw[i * 2] = pr; apw[i * 2 + 1] = pi; }
        for (int i = TID_; i < 64 * 16; i += 512) { const int p = i >> 4, c2 = i & 15; const S5P s = s5_param(P, l, g, p);
            const float br = in_ptr(16)[(((size_t)l * 32 + g) * 64 + p) * 16 + c2], bi = in_ptr(17)[(((size_t)l * 32 + g) * 64 + p) * 16 + c2];
            bb[i * 2] = s.cr * br - s.ci * bi; bb[i * 2 + 1] = s.cr * bi + s.ci * br; }
        for (int i = TID_; i < 16 * 64; i += 512) { cc[i * 2] = in_ptr(18)[((size_t)l * 32 + g) * 1024 + i]; cc[i * 2 + 1] = in_ptr(19)[((size_t)l * 32 + g) * 1024 + i]; }
        __syncthreads();
        for (int i = TID_; i < 4 * 256; i += 512) { const int c2 = i & 15, c = (i >> 4) & 15, d = sub * 4 + (i >> 8);
            float acc = 0.f;
            for (int p = 0; p < 64; ++p) { const float pr = apw[(p * 34 + d) * 2], pi = apw[(p * 34 + d) * 2 + 1], bbr = bb[(p * 16 + c2) * 2], bbi = bb[(p * 16 + c2) * 2 + 1];
                const float xr = pr * bbr - pi * bbi, xi = pr * bbi + pi * bbr; acc += cc[(c * 64 + p) * 2] * xr - cc[(c * 64 + p) * 2 + 1] * xi; }
            if (d == 0 && c == c2) acc += in_ptr(20)[(size_t)l * 512 + g * 16 + c];
            km[(((size_t)g * 32 + d) * 16 + c) * 16 + c2] = acc; }
        for (int i = TID_; i < 32 * 512; i += 512) { const int k = i & 511, n = sub * 32 + (i >> 9); float v = 0.f;
            if (n < 128) { const int p = n & 63, s_ = k >> 4, c2 = k & 15; const float pr = apw[(p * 34 + 31 - s_) * 2], pi = apw[(p * 34 + 31 - s_) * 2 + 1], bbr = bb[(p * 16 + c2) * 2], bbi = bb[(p * 16 + c2) * 2 + 1];
                v = n < 64 ? (pr * bbr - pi * bbi) : (pr * bbi + pi * bbr); }
            wt[((size_t)g * 256 + n) * 512 + k] = f2bf(v); }
        for (int i = TID_; i < 64 * 256; i += 512) { const int k = i & 255, n = sub * 64 + (i >> 8); float v = 0.f;
            if (k < 128) { const int p = k & 63, t = n >> 4, c = n & 15; const float pr = apw[(p * 34 + t + 1) * 2], pi = apw[(p * 34 + t + 1) * 2 + 1], cre = cc[(c * 64 + p) * 2], cim = cc[(c * 64 + p) * 2 + 1];
                v = k < 64 ? (cre * pr - cim * pi) : -(cre * pi + cim * pr); }
            vt[((size_t)g * 512 + n) * 256 + k] = f2bf(v); }
    }
    __syncthreads();
}
__device__ __forceinline__ void phase_s5_toeplitz(const Params& P) {
    OPQ_IDS
    unsigned char* ws = P.ws; asm volatile("" : "+s"(ws)); const int gtid = BID_ * 512 + TID_, gsz = NBLK_ * 512;
    const float* km = (const float*)(ws + WS.s5pow); bf16_t* tt = (bf16_t*)(ws + WS.s5t);
    for (int i = gtid; i < 32 * 512 * 64; i += gsz) {
        const int k8 = i & 63, n = (i >> 6) & 511, g = i >> 15; const int t = n >> 4, c = n & 15, s_ = k8 >> 1, c2 = (k8 & 1) * 8;
        float v[8];
#pragma unroll
        for (int j = 0; j < 8; ++j) v[j] = s_ <= t ? km[(((size_t)g * 32 + (t - s_)) * 16 + c) * 16 + c2 + j] : 0.f;
        u32x4 w; w.x = cvt_pk_bf16(v[0], v[1]); w.y = cvt_pk_bf16(v[2], v[3]); w.z = cvt_pk_bf16(v[4], v[5]); w.w = cvt_pk_bf16(v[6], v[7]);
        *(u32x4*)(tt + ((size_t)g * 512 + n) * 512 + k8 * 8) = w; }
}

__device__ __forceinline__ void phase_rmsnorm(const float* x, const float* g, bf16_t* h) {
    OPQ_IDS
    const int lane = TID_ & 63, wv = TID_ >> 6;
    f32x4 gv[8];
#pragma unroll
    for (int i = 0; i < 8; ++i) gv[i] = *(const f32x4*)(g + (i * 64 + lane) * 4);
    for (int r = BID_ * 8 + wv; r < T_; r += NBLK_ * 8) {
        const float* xr = x + (size_t)r * DM; f32x4 v[8]; float ss = 0.f;
#pragma unroll
        for (int i = 0; i < 8; ++i) { v[i] = *(const f32x4*)(xr + (i * 64 + lane) * 4); ss += v[i][0] * v[i][0] + v[i][1] * v[i][1] + v[i][2] * v[i][2] + v[i][3] * v[i][3]; }
        ss = wave_sum(ss); const float rs = rsqrtf(ss * (1.f / DM) + 1e-6f);
#pragma unroll
        for (int i = 0; i < 8; ++i) { u32x2 w; w.x = cvt_pk_bf16(v[i][0] * rs * gv[i][0], v[i][1] * rs * gv[i][1]); w.y = cvt_pk_bf16(v[i][2] * rs * gv[i][2], v[i][3] * rs * gv[i][3]);
            *(u32x2*)(h + (size_t)r * DM + (i * 64 + lane) * 4) = w; }
    }
}

__device__ __forceinline__ void unpack8(const u32x4 a, float* v) { v[0] = bflo(a.x); v[1] = bfhi(a.x); v[2] = bflo(a.y); v[3] = bfhi(a.y); v[4] = bflo(a.z); v[5] = bfhi(a.z); v[6] = bflo(a.w); v[7] = bfhi(a.w); }
__device__ __forceinline__ u32x4 pack8f(const float* v) { u32x4 w; w.x = cvt_pk_bf16(v[0], v[1]); w.y = cvt_pk_bf16(v[2], v[3]); w.z = cvt_pk_bf16(v[4], v[5]); w.w = cvt_pk_bf16(v[6], v[7]); return w; }
__device__ __forceinline__ void phase_post_inproj(const Params& P, int l) {
    OPQ_IDS
    unsigned char* ws = P.ws; asm volatile("" : "+s"(ws)); const int lane = TID_ & 63, wv = TID_ >> 6;
    bf16_t* cols = (bf16_t*)(ws + WS.cols); const float* rope = (const float*)(ws + WS.rope);
    const float* gq = in_ptr(3) + (size_t)l * 448; const float* gkv = in_ptr(4) + (size_t)l * 128;
    bf16_t* cqn = (bf16_t*)(ws + WS.cqn); bf16_t* ckvn = (bf16_t*)(ws + WS.ckvn); bf16_t* krope = (bf16_t*)(ws + WS.krope);
    bf16_t* pd = (bf16_t*)(ws + WS.pd); bf16_t* ud = (bf16_t*)(ws + WS.ud); bf16_t* kcc = (bf16_t*)(ws + WS.kcc); bf16_t* vcc = (bf16_t*)(ws + WS.vcc);
    const u32x4 zero4 = {0u, 0u, 0u, 0u};
    for (int r = BID_ * 8 + wv; r < T_; r += NBLK_ * 8) {
        const int s = r & (S_ - 1); bf16_t* row = cols + (size_t)r * NINP;
        const u32x4 q8 = lane < 56 ? *(const u32x4*)(row + C_CQ + lane * 8) : zero4;
        const u32x4 kv8 = lane < 16 ? *(const u32x4*)(row + C_CKV + lane * 8) : zero4;
        const u32x4 u8 = *(const u32x4*)(row + C_CC + lane * 8);
        const u32x4 d8 = *(const u32x4*)(row + C_CD + lane * 8);
        const int w = 2 << (lane >> 4);
        u32x4 pw[15];
#pragma unroll
        for (int q = 1; q < 16; ++q) pw[q - 1] = (q < w && s - q >= 0) ? *(const u32x4*)(row - (size_t)q * NINP + C_CC + lane * 8) : zero4;
        const int rt = lane >> 1, rh = lane & 1; const int rbase = rt == 0 ? C_KROPE : (rt == 1 ? C_KC : (rt == 2 ? C_KS : C_KW));
        u32x4 r1 = zero4, r2 = zero4; if (lane < 8) { r1 = *(const u32x4*)(row + rbase + rh * 8); r2 = *(const u32x4*)(row + rbase + 16 + rh * 8); }
        const u32x4 kc8 = (lane >= 4 && lane < 16) ? *(const u32x4*)(row + C_KC + lane * 8) : zero4;
        const u32x4 vc8 = lane < 16 ? *(const u32x4*)(row + C_VC + lane * 8) : zero4;
        { float v[8]; unpack8(q8, v); float ss = 0.f;
#pragma unroll
          for (int j = 0; j < 8; ++j) ss += v[j] * v[j];
          ss = wave_sum(ss); const float rs = rsqrtf(ss * (1.f / 448.f) + 1e-6f);
          if (lane < 56) { const f32x4 g0 = *(const f32x4*)(gq + lane * 8), g1 = *(const f32x4*)(gq + lane * 8 + 4);
#pragma unroll
              for (int j = 0; j < 4; ++j) { v[j] *= rs * g0[j]; v[4 + j] *= rs * g1[j]; } }
          *(u32x4*)(cqn + (size_t)r * 512 + lane * 8) = lane < 56 ? pack8f(v) : zero4; }
        { float v[8]; unpack8(kv8, v); float ss = 0.f;
#pragma unroll
          for (int j = 0; j < 8; ++j) ss += v[j] * v[j];
          ss = wave_sum(ss); const float rs = rsqrtf(ss * (1.f / 128.f) + 1e-6f);
          if (lane < 16) { const f32x4 g0 = *(const f32x4*)(gkv + lane * 8), g1 = *(const f32x4*)(gkv + lane * 8 + 4);
#pragma unroll
              for (int j = 0; j < 4; ++j) { v[j] *= rs * g0[j]; v[4 + j] *= rs * g1[j]; } }
          if (lane < 32) *(u32x4*)(ckvn + (size_t)r * 256 + lane * 8) = lane < 16 ? pack8f(v) : zero4; }
        if (lane < 8) { float x1[8], x2[8], o1[8], o2[8]; unpack8(r1, x1); unpack8(r2, x2);
            const f32x4 c0 = *(const f32x4*)(rope + s * 32 + rh * 8), c1 = *(const f32x4*)(rope + s * 32 + rh * 8 + 4), s0 = *(const f32x4*)(rope + s * 32 + 16 + rh * 8), s1 = *(const f32x4*)(rope + s * 32 + 16 + rh * 8 + 4);
#pragma unroll
            for (int j = 0; j < 8; ++j) { const float cs = j < 4 ? c0[j] : c1[j - 4], sn = j < 4 ? s0[j] : s1[j - 4]; o1[j] = x1[j] * cs - x2[j] * sn; o2[j] = x2[j] * cs + x1[j] * sn; }
            const u32x4 w1 = pack8f(o1), w2 = pack8f(o2);
            if (rt == 0) { *(u32x4*)(krope + (size_t)r * 32 + rh * 8) = w1; *(u32x4*)(krope + (size_t)r * 32 + 16 + rh * 8) = w2; }
            else { *(u32x4*)(row + rbase + rh * 8) = w1; *(u32x4*)(row + rbase + 16 + rh * 8) = w2; }
            if (rt == 1) { *(u32x4*)(kcc + (size_t)r * 128 + rh * 8) = w1; *(u32x4*)(kcc + (size_t)r * 128 + 16 + rh * 8) = w2; } }
        if (lane >= 4 && lane < 16) *(u32x4*)(kcc + (size_t)r * 128 + lane * 8) = kc8;
        if (lane < 16) *(u32x4*)(vcc + (size_t)r * 128 + lane * 8) = vc8;
        { float u[8], acc[8], t[8]; unpack8(u8, u);
#pragma unroll
          for (int j = 0; j < 8; ++j) acc[j] = u[j];
#pragma unroll
          for (int q = 1; q < 16; ++q) { unpack8(pw[q - 1], t);
#pragma unroll
              for (int j = 0; j < 8; ++j) acc[j] += t[j]; }
          const int cnt = s + 1 < w ? s + 1 : w; const float inv = 1.f / (float)cnt;
#pragma unroll
          for (int j = 0; j < 8; ++j) acc[j] = acc[j] * inv - u[j];
          *(u32x4*)(pd + (size_t)r * 512 + lane * 8) = pack8f(acc); }
        *(u32x4*)(ud + ((size_t)(lane >> 1) * S5ROWS + (r >> 5)) * 512 + (r & 31) * 16 + (lane & 1) * 8) = d8;
    }
}

__device__ __forceinline__ void phase_cmp_finish(const Params& P, int l, LAS float* sm) {
    OPQ_IDS
    unsigned char* ws = P.ws; asm volatile("" : "+s"(ws)); const int tid = TID_, sub = tid >> 7, j = tid & 127;
    for (int base = BID_ * 4; base < 2 * NB_ * 128; base += NBLK_ * 4) {
        const int it = base + sub;
        const int kv = it / (NB_ * 128), b = (it / 128) % NB_, n = it & 127;
        const float* z = (const float*)(ws + (kv ? WS.zv : WS.zk)); bf16_t* out = (bf16_t*)(ws + (kv ? WS.vcmp : WS.kcmp)) + ((size_t)b * 128 + n) * 128;
        LAS float* g = sm + sub * 128;
        float hv = 0.f;
        if (n < 127) { float pre = ((const float*)(ws + WS.cmpb1))[kv * 128 + j];
#pragma unroll
            for (int q = 0; q < 4; ++q) pre += z[(size_t)q * 1024 * 256 + ((size_t)b * 128 + n) * 256 + j] + z[(size_t)q * 1024 * 256 + ((size_t)b * 128 + n + 1) * 256 + 128 + j];
            hv = gelu_tanh(pre); }
        __syncthreads();
        g[j] = hv;
        __syncthreads();
        float acc = 0.f;
        if (n < 127) { const float* w2 = in_ptr(9) + ((size_t)l * 2 + kv) * 128 * 128; for (int k = 0; k < 128; ++k) acc += g[k] * w2[(size_t)k * 128 + j]; }
        out[j] = f2bf(acc);
    }
}

__device__ __forceinline__ void phase_s5_scan(const Params& P, int l) {
    OPQ_IDS
    unsigned char* ws = P.ws; asm volatile("" : "+s"(ws)); const float* xend = (const float*)(ws + WS.xend); bf16_t* xprev = (bf16_t*)(ws + WS.xprev);
    for (int i = BID_ * 512 + TID_; i < NB_ * 32 * 64; i += NBLK_ * 512) { const int p = i & 63, g = (i >> 6) & 31, b = i >> 11;
        const S5P s = s5_param(P, l, g, p); float ar, ai; s5_apow(s, 32, ar, ai); float xr = 0.f, xi = 0.f;
        for (int k0 = 0; k0 < 64; k0 += 16) { float er[16], ei[16];
#pragma unroll
            for (int k = 0; k < 16; ++k) { const size_t row = (size_t)g * S5ROWS + b * 64 + k0 + k; er[k] = xend[row * 128 + p]; ei[k] = xend[row * 128 + 64 + p]; }
#pragma unroll
            for (int k = 0; k < 16; ++k) { const size_t row = (size_t)g * S5ROWS + b * 64 + k0 + k;
                xprev[row * 256 + p] = f2bf(xr); xprev[row * 256 + 64 + p] = f2bf(xi); xprev[row * 256 + 128 + p] = 0; xprev[row * 256 + 192 + p] = 0;
                const float nr = ar * xr - ai * xi + er[k], ni = ar * xi + ai * xr + ei[k]; xr = nr; xi = ni; } }
    }
}

__device__ __forceinline__ void phase_mixnorm(const Params& P, int l) {
    OPQ_IDS
    unsigned char* ws = P.ws; asm volatile("" : "+s"(ws)); const int lane = TID_ & 63, wv = TID_ >> 6;
    bf16_t* ycat = (bf16_t*)(ws + WS.ycat); const bf16_t* oc = (const bf16_t*)(ws + WS.oc); const bf16_t* os = (const bf16_t*)(ws + WS.os); const bf16_t* ow = (const bf16_t*)(ws + WS.ow);
    const float* g = in_ptr(23) + (size_t)l * DM;
    for (int r = BID_ * 8 + wv; r < T_; r += NBLK_ * 8) {
#pragma unroll
        for (int grp = 0; grp < 4; ++grp) { float v[8];
            const u32x4 a = *(const u32x4*)(ycat + (size_t)r * DM + grp * 512 + lane * 8);
            v[0] = bflo(a.x); v[1] = bfhi(a.x); v[2] = bflo(a.y); v[3] = bfhi(a.y); v[4] = bflo(a.z); v[5] = bfhi(a.z); v[6] = bflo(a.w); v[7] = bfhi(a.w);
            if (grp == 1) { const u32x4 b = *(const u32x4*)(oc + (size_t)r * 512 + lane * 8), c = *(const u32x4*)(os + (size_t)r * 512 + lane * 8), d = *(const u32x4*)(ow + (size_t)r * 512 + lane * 8);
                v[0] = bflo(b.x) + bflo(c.x) + bflo(d.x); v[1] = bfhi(b.x) + bfhi(c.x) + bfhi(d.x); v[2] = bflo(b.y) + bflo(c.y) + bflo(d.y); v[3] = bfhi(b.y) + bfhi(c.y) + bfhi(d.y);
                v[4] = bflo(b.z) + bflo(c.z) + bflo(d.z); v[5] = bfhi(b.z) + bfhi(c.z) + bfhi(d.z); v[6] = bflo(b.w) + bflo(c.w) + bflo(d.w); v[7] = bfhi(b.w) + bfhi(c.w) + bfhi(d.w); }
            float ss = 0.f;
#pragma unroll
            for (int j = 0; j < 8; ++j) ss += v[j] * v[j];
            ss = wave_sum(ss); const float rs = rsqrtf(ss * (1.f / 512.f) + 1e-6f);
            const f32x4 g0 = *(const f32x4*)(g + grp * 512 + lane * 8), g1 = *(const f32x4*)(g + grp * 512 + lane * 8 + 4);
            u32x4 w; w.x = cvt_pk_bf16(v[0] * rs * g0[0], v[1] * rs * g0[1]); w.y = cvt_pk_bf16(v[2] * rs * g0[2], v[3] * rs * g0[3]);
            w.z = cvt_pk_bf16(v[4] * rs * g1[0], v[5] * rs * g1[1]); w.w = cvt_pk_bf16(v[6] * rs * g1[2], v[7] * rs * g1[3]);
            *(u32x4*)(ycat + (size_t)r * DM + grp * 512 + lane * 8) = w; }
    }
}

__device__ __forceinline__ void phase_route(const Params& P, int l) {
    OPQ_IDS
    unsigned char* ws = P.ws; asm volatile("" : "+s"(ws)); const float* lg = (const float*)(ws + WS.logits); unsigned* cnt = (unsigned*)(ws + WS.ctl) + CW_CNT + l * 2048;
    int* mlist = (int*)(ws + WS.mlist); float* mwt = (float*)(ws + WS.mwt); int* mtok = (int*)(ws + WS.mtok);
    const float* bg = in_ptr(27) + (size_t)l * 4; const float* be = in_ptr(29) + (size_t)l * 32;
    for (int t = BID_ * 512 + TID_; t < T_; t += NBLK_ * 512) {
        const float* r = lg + (size_t)t * 64; constexpr size_t PS = (size_t)T_ * 64;
        float gl[4]; float gm = -1e30f; int gi = 0;
#pragma unroll
        for (int i = 0; i < 4; ++i) { gl[i] = ((r[i] + r[PS + i]) + (r[2 * PS + i] + r[3 * PS + i])) + bg[i]; if (gl[i] > gm) { gm = gl[i]; gi = i; } }
        float gs = 0.f;
#pragma unroll
        for (int i = 0; i < 4; ++i) gs += __expf(gl[i] - gm);
        const float ptop = 1.f / gs;
        float el[8]; float em = -1e30f;
#pragma unroll
        for (int i = 0; i < 8; ++i) { const int c = 4 + gi * 8 + i; el[i] = ((r[c] + r[PS + c]) + (r[2 * PS + c] + r[3 * PS + c])) + be[gi * 8 + i]; em = fmaxf(em, el[i]); }
        float es = 0.f;
#pragma unroll
        for (int i = 0; i < 8; ++i) { el[i] = __expf(el[i] - em); es += el[i]; }
        float p1 = -1.f, p2 = -1.f; int i1 = 0, i2 = 0;
#pragma unroll
        for (int i = 0; i < 8; ++i) { const float p = el[i]; if (p > p1) { p2 = p1; i2 = i1; p1 = p; i1 = i; } else if (p > p2) { p2 = p; i2 = i; } }
        const float inv = 1.f / (p1 + p2); const float w1 = ptop * p1 * inv, w2 = ptop * p2 * inv;
        const int e1 = gi * 8 + i1, e2 = gi * 8 + i2;
        int s1 = 0, s2 = 0;
        { const unsigned long long lt = (1ull << (TID_ & 63)) - 1ull;
          unsigned long long todo = __ballot(1);
          while (todo) { const int e = __builtin_amdgcn_readfirstlane(e1); const unsigned long long m = __ballot(e1 == e) & todo; unsigned base = 0;
              if ((TID_ & 63) == (int)__builtin_ctzll(m)) base = atomicAdd(&cnt[e * 64], (unsigned)__builtin_popcountll(m));
              base = (unsigned)__builtin_amdgcn_readlane((int)base, (int)__builtin_ctzll(m));
              if (e1 == e) s1 = (int)base + (int)__builtin_popcountll(m & lt);
              todo &= ~m; if (e1 == e) break; }
          todo = __ballot(1);
          while (todo) { const int e = __builtin_amdgcn_readfirstlane(e2); const unsigned long long m = __ballot(e2 == e) & todo; unsigned base = 0;
              if ((TID_ & 63) == (int)__builtin_ctzll(m)) base = atomicAdd(&cnt[e * 64], (unsigned)__builtin_popcountll(m));
              base = (unsigned)__builtin_amdgcn_readlane((int)base, (int)__builtin_ctzll(m));
              if (e2 == e) s2 = (int)base + (int)__builtin_popcountll(m & lt);
              todo &= ~m; if (e2 == e) break; } }
        mlist[(size_t)e1 * T_ + s1] = t; mwt[(size_t)e1 * T_ + s1] = w1; mlist[(size_t)e2 * T_ + s2] = t; mwt[(size_t)e2 * T_ + s2] = w2;
        mtok[t * 4 + 0] = e1; mtok[t * 4 + 1] = s1; mtok[t * 4 + 2] = e2; mtok[t * 4 + 3] = s2;
    }
}


__device__ __forceinline__ void phase_moe_gather(const Params& P, const LAS int* tiles, const LAS int* cnt) {
    OPQ_IDS
    unsigned char* ws = P.ws; asm volatile("" : "+s"(ws));
    const int lane = TID_ & 63, wv = TID_ >> 6;
    const int* mlist = (const int*)(ws + WS.mlist); const bf16_t* h = (const bf16_t*)(ws + WS.h); bf16_t* xg = (bf16_t*)(ws + WS_XG);
    const int total = tiles[32] * 256;
    for (int r0 = (BID_ * 8 + wv) * 4; r0 < total; r0 += NBLK_ * 32) {
        int tok[4];
#pragma unroll
        for (int q = 0; q < 4; ++q) { const int r = r0 + q; const int tile = r >> 8; int e = 0;
#pragma unroll 1
            while (e < 31 && tile >= tiles[e + 1]) ++e;
            const int slot = r - tiles[e] * 256; tok[q] = (r < total && slot < cnt[e]) ? mlist[(size_t)e * T_ + slot] : -1; }
        u32x4 v[4][4];
#pragma unroll
        for (int q = 0; q < 4; ++q)
#pragma unroll
            for (int i = 0; i < 4; ++i) v[q][i] = tok[q] >= 0 ? *(const u32x4*)(h + (size_t)tok[q] * DM + (i * 64 + lane) * 8) : (u32x4){0u, 0u, 0u, 0u};
#pragma unroll
        for (int q = 0; q < 4; ++q) if (tok[q] >= 0) {
#pragma unroll
            for (int i = 0; i < 4; ++i) *(u32x4*)(xg + (size_t)(r0 + q) * DM + (i * 64 + lane) * 8) = v[q][i]; }
    }
}

__device__ __forceinline__ void phase_combine(const Params& P, int l, const LAS int* tiles, const float* g, bool final_) {
    OPQ_IDS
    unsigned char* ws = P.ws; asm volatile("" : "+s"(ws)); const int lane = TID_ & 63, wv = TID_ >> 6;
    const bf16_t* yd = (const bf16_t*)(ws + WS.yd); const int* mtok = (const int*)(ws + WS.mtok); bf16_t* h = (bf16_t*)(ws + WS.h); float* x = P.out;
    for (int r = BID_ * 8 + wv; r < T_; r += NBLK_ * 8) {
        const int e1 = mtok[r * 4 + 0], s1 = mtok[r * 4 + 1], e2 = mtok[r * 4 + 2], s2 = mtok[r * 4 + 3];
        const size_t c1 = (size_t)tiles[e1] * 256 + s1, c2 = (size_t)tiles[e2] * 256 + s2;
        float v[32]; float ss = 0.f;
#pragma unroll
        for (int i = 0; i < 4; ++i) { const int c = (i * 64 + lane) * 8; const f32x4 x0 = *(const f32x4*)(x + (size_t)r * DM + c), x1 = *(const f32x4*)(x + (size_t)r * DM + c + 4);
            const u32x4 a = *(const u32x4*)(yd + c1 * DM + c), b = *(const u32x4*)(yd + c2 * DM + c);
            v[i * 8 + 0] = x0[0] + bflo(a.x) + bflo(b.x); v[i * 8 + 1] = x0[1] + bfhi(a.x) + bfhi(b.x); v[i * 8 + 2] = x0[2] + bflo(a.y) + bflo(b.y); v[i * 8 + 3] = x0[3] + bfhi(a.y) + bfhi(b.y);
            v[i * 8 + 4] = x1[0] + bflo(a.z) + bflo(b.z); v[i * 8 + 5] = x1[1] + bfhi(a.z) + bfhi(b.z); v[i * 8 + 6] = x1[2] + bflo(a.w) + bflo(b.w); v[i * 8 + 7] = x1[3] + bfhi(a.w) + bfhi(b.w);
#pragma unroll
            for (int j = 0; j < 8; ++j) ss += v[i * 8 + j] * v[i * 8 + j]; }
        ss = wave_sum(ss); const float rs = rsqrtf(ss * (1.f / DM) + 1e-6f);
#pragma unroll
        for (int i = 0; i < 4; ++i) { const int c = (i * 64 + lane) * 8; const f32x4 g0 = *(const f32x4*)(g + c), g1 = *(const f32x4*)(g + c + 4);
            if (final_) { f32x4 o0, o1;
#pragma unroll
                for (int j = 0; j < 4; ++j) { o0[j] = v[i * 8 + j] * rs * g0[j]; o1[j] = v[i * 8 + 4 + j] * rs * g1[j]; }
                *(f32x4*)(x + (size_t)r * DM + c) = o0; *(f32x4*)(x + (size_t)r * DM + c + 4) = o1; }
            else { f32x4 o0, o1;
#pragma unroll
                for (int j = 0; j < 4; ++j) { o0[j] = v[i * 8 + j]; o1[j] = v[i * 8 + 4 + j]; }
                *(f32x4*)(x + (size_t)r * DM + c) = o0; *(f32x4*)(x + (size_t)r * DM + c + 4) = o1;
                u32x4 w; w.x = cvt_pk_bf16(v[i * 8 + 0] * rs * g0[0], v[i * 8 + 1] * rs * g0[1]); w.y = cvt_pk_bf16(v[i * 8 + 2] * rs * g0[2], v[i * 8 + 3] * rs * g0[3]);
                w.z = cvt_pk_bf16(v[i * 8 + 4] * rs * g1[0], v[i * 8 + 5] * rs * g1[1]); w.w = cvt_pk_bf16(v[i * 8 + 6] * rs * g1[2], v[i * 8 + 7] * rs * g1[3]);
                *(u32x4*)(h + (size_t)r * DM + c) = w; } }
    }
}

namespace at {
constexpr int SHM_K = 16384, SHM_V = 16384;
constexpr int OFF_V = 0, OFF_K = 32768, OFF_WS = 65536  , OFF_SEL = 65536 + 2048  , OFF_IMP = 69632  ;
constexpr float SCALE = 0.08838834764831845f, C2 = 1.4426950408889634f * SCALE;
#define KSWZ(row, colB) ((row) * 256 + ((colB) ^ (((row) & 7) << 4)))
__device__ __forceinline__ int v_st(int k, int c) { const int kk = (k & ~0xC) | ((k & 4) << 1) | ((k & 8) >> 1); return ((kk >> 3) * 4 + (c >> 5)) * 512 + ((kk & 7) * 32 + (c & 31)) * 2; }
__device__ __forceinline__ int v_rd_base(int lane) { return ((lane & 3) << 3) | (((lane >> 2) & 3) << 6) | (((lane >> 4) & 1) << 5) | (((lane >> 5) & 1) << 8); }
constexpr int v_rd_off(int d0, int ks, int half) { return d0 * 512 + ks * 4096 + half * 2048; }
__device__ __forceinline__ int crow(int r, int hi) { return (r & 3) + 8 * (r >> 2) + 4 * hi; }

__device__ __forceinline__ void qkt(f32x16& p0, f32x16& p1, const LAS char* Kb, int r32, int hi, const bf16x8* qr) {
    p0 = f32x16{}; p1 = f32x16{};
    const LAS char* kb[4];
#pragma unroll
    for (int dd = 0; dd < 4; ++dd) kb[dd] = Kb + KSWZ(r32, (dd * 16 + hi * 8) * 2);
#pragma unroll
    for (int d0 = 0; d0 < 8; ++d0) { const LAS char* a = kb[d0 & 3] + (d0 >> 2) * 128;
        const bf16x8 b0 = *reinterpret_cast<const LAS bf16x8*>(a);
        const bf16x8 b1 = *reinterpret_cast<const LAS bf16x8*>(a + 32 * 256);
        p0 = __builtin_amdgcn_mfma_f32_32x32x16_bf16(b0, qr[d0], p0, 0, 0, 0);
        p1 = __builtin_amdgcn_mfma_f32_32x32x16_bf16(b1, qr[d0], p1, 0, 0, 0); }
}
__device__ __forceinline__ void pv_tile(f32x16* o, int vb0, bf16x8 pa0, bf16x8 pa1, bf16x8 pa2, bf16x8 pa3) {
#define TRRD(dst, off) asm volatile("ds_read_b64_tr_b16 %0, %1 offset:%2" : "=&v"(dst) : "v"(vb0), "i"(off) : "memory")
#define PV_D0(d0) do { s16x4 l0, l1, l2, l3, h0, h1, h2, h3; constexpr int b_ = v_rd_off(d0, 0, 0); \
        TRRD(l0, b_); TRRD(h0, b_ + 2048); TRRD(l1, b_ + 4096); TRRD(h1, b_ + 6144); TRRD(l2, b_ + 8192); TRRD(h2, b_ + 10240); TRRD(l3, b_ + 12288); TRRD(h3, b_ + 14336); \
        asm volatile("s_waitcnt lgkmcnt(0)" ::: "memory"); __builtin_amdgcn_sched_barrier(0); \
        o[d0] = __builtin_amdgcn_mfma_f32_32x32x16_bf16(pa0, (bf16x8){l0[0], l0[1], l0[2], l0[3], h0[0], h0[1], h0[2], h0[3]}, o[d0], 0, 0, 0); \
        o[d0] = __builtin_amdgcn_mfma_f32_32x32x16_bf16(pa1, (bf16x8){l1[0], l1[1], l1[2], l1[3], h1[0], h1[1], h1[2], h1[3]}, o[d0], 0, 0, 0); \
        o[d0] = __builtin_amdgcn_mfma_f32_32x32x16_bf16(pa2, (bf16x8){l2[0], l2[1], l2[2], l2[3], h2[0], h2[1], h2[2], h2[3]}, o[d0], 0, 0, 0); \
        o[d0] = __builtin_amdgcn_mfma_f32_32x32x16_bf16(pa3, (bf16x8){l3[0], l3[1], l3[2], l3[3], h3[0], h3[1], h3[2], h3[3]}, o[d0], 0, 0, 0); } while (0)
    PV_D0(0); PV_D0(1); PV_D0(2); PV_D0(3);
#undef PV_D0
#undef TRRD
}
__device__ __forceinline__ void mask_tile(f32x16& p0, f32x16& p1, int dq, unsigned W) {
    const float NEG = -__builtin_inff();
#pragma unroll
    for (int r = 0; r < 16; ++r) { const int c = (r & 3) + 8 * (r >> 2);
        if ((unsigned)(dq - c) >= W) p0[r] = NEG;
        if ((unsigned)(dq - c - 32) >= W) p1[r] = NEG; }
}
__device__ __forceinline__ float half_swap_max(float v) { auto rr = __builtin_amdgcn_permlane32_swap(__float_as_uint(v), __float_as_uint(v), false, false); return fmaxf(__uint_as_float(rr[0]), __uint_as_float(rr[1])); }
__device__ __forceinline__ float half_swap_sum(float v) { auto rr = __builtin_amdgcn_permlane32_swap(__float_as_uint(v), __float_as_uint(v), false, false); return __uint_as_float(rr[0]) + __uint_as_float(rr[1]); }
__device__ __forceinline__ void pack_p(const f32x16& p0, const f32x16& p1, bf16x8& pa0, bf16x8& pa1, bf16x8& pa2, bf16x8& pa3) {
#define PK4(P, B_, OUT) do { unsigned a0 = cvt_pk_bf16(P[B_+0], P[B_+1]), a1 = cvt_pk_bf16(P[B_+2], P[B_+3]); \
        unsigned b0 = cvt_pk_bf16(P[B_+4], P[B_+5]), b1 = cvt_pk_bf16(P[B_+6], P[B_+7]); \
        auto r0 = __builtin_amdgcn_permlane32_swap(a0, b0, false, false); auto r1 = __builtin_amdgcn_permlane32_swap(a1, b1, false, false); \
        u32x4 w = {r0[0], r1[0], r0[1], r1[1]}; OUT = *reinterpret_cast<bf16x8*>(&w); } while (0)
    PK4(p0, 0, pa0); PK4(p0, 8, pa1); PK4(p1, 0, pa2); PK4(p1, 8, pa3);
#undef PK4
}

struct Job {
    const bf16_t* Q; int ldq;
    const bf16_t* K; int ldk; const bf16_t* Kalt; int ldkalt;
    const bf16_t* V; int ldv;
    bf16_t* O; int ldo;
    const bf16_t* gate; int ldg, gofs;
    const float* rope; int rope_d0;
    int nsa;
    int head;
    int pos0;
};

__device__ __forceinline__ void load_q(bf16x8* qr, const Job& jb, int qpos, int head, int hi) {
    const bf16_t* qp = jb.Q + (size_t)qpos * jb.ldq + head * 128 + hi * 8;
#pragma unroll
    for (int d0 = 0; d0 < 8; ++d0) qr[d0] = *reinterpret_cast<const bf16x8*>(qp + d0 * 16);
    const float* rp = jb.rope + qpos * 32 + hi * 8;
    f32x4 c0 = *(const f32x4*)rp, c1 = *(const f32x4*)(rp + 4), s0 = *(const f32x4*)(rp + 16), s1 = *(const f32x4*)(rp + 20);
    float cs[8] = {c0[0], c0[1], c0[2], c0[3], c1[0], c1[1], c1[2], c1[3]}, sn[8] = {s0[0], s0[1], s0[2], s0[3], s1[0], s1[1], s1[2], s1[3]};
#define ROPE_AT(D) do { bf16x8 a = qr[D], b = qr[D + 1]; \
        _Pragma("unroll") for (int j = 0; j < 8; ++j) { const float x1 = bf2f((bf16_t)a[j]), x2 = bf2f((bf16_t)b[j]); a[j] = (short)f2bf(x1 * cs[j] - x2 * sn[j]); b[j] = (short)f2bf(x2 * cs[j] + x1 * sn[j]); } \
        qr[D] = a; qr[D + 1] = b; } while (0)
    if (jb.rope_d0 == 0) ROPE_AT(0); else ROPE_AT(6);
#undef ROPE_AT
}

struct Stage { bf16x8 k0, k1, v0, v1; };
__device__ __forceinline__ void stage_load(Stage& st, const Job& jb, int kb, int sr, int sch) {
    const size_t r0 = (size_t)(kb + sr), r1 = (size_t)(kb + 32 + sr);
    if (jb.Kalt && sch >= 12) { st.k0 = *reinterpret_cast<const bf16x8*>(jb.Kalt + r0 * jb.ldkalt + (sch - 12) * 8); st.k1 = *reinterpret_cast<const bf16x8*>(jb.Kalt + r1 * jb.ldkalt + (sch - 12) * 8); }
    else { st.k0 = *reinterpret_cast<const bf16x8*>(jb.K + r0 * jb.ldk + sch * 8); st.k1 = *reinterpret_cast<const bf16x8*>(jb.K + r1 * jb.ldk + sch * 8); }
    st.v0 = *reinterpret_cast<const bf16x8*>(jb.V + r0 * jb.ldv + sch * 8); st.v1 = *reinterpret_cast<const bf16x8*>(jb.V + r1 * jb.ldv + sch * 8);
}
__device__ __forceinline__ void stage_write(const Stage& st, LAS char* lds, int buf, int sr, int sch) {
    LAS char* Kb = lds + OFF_K + buf * SHM_K; LAS char* Vb = lds + OFF_V + buf * SHM_V;
    const int kws = KSWZ(sr, sch * 16);
    *reinterpret_cast<LAS bf16x8*>(Kb + kws) = st.k0; *reinterpret_cast<LAS bf16x8*>(Kb + kws + 32 * 256) = st.k1;
    *reinterpret_cast<LAS bf16x8*>(Vb + v_st(sr, sch * 8)) = st.v0; *reinterpret_cast<LAS bf16x8*>(Vb + v_st(32 + sr, sch * 8)) = st.v1;
}

__device__ __forceinline__ void store_o(const f32x16* o, float l_reg, const Job& jb, LAS float* wsf, int qpos0w, int head, int r32, int hi) {
    float sc = l_reg > 0.f ? 1.f / l_reg : 0.f;
    if (jb.gate) sc *= sigmoidf_(bf2f(jb.gate[(size_t)(qpos0w + r32) * jb.ldg + jb.gofs + 3 * head]));
    if (hi == 0) wsf[r32] = sc;
    asm volatile("s_waitcnt lgkmcnt(0)" ::: "memory");
    bf16_t* Ow = jb.O + (size_t)qpos0w * jb.ldo + head * 128;
#pragma unroll
    for (int r = 0; r < 16; ++r) { const int orow = crow(r, hi); const float s = wsf[orow];
#pragma unroll
        for (int d0 = 0; d0 < 4; ++d0) { const float v = o[d0][r] * s; const float vn = __shfl_xor(v, 1);
            if ((r32 & 1) == 0) *(unsigned*)(Ow + (size_t)orow * jb.ldo + d0 * 32 + r32) = cvt_pk_bf16(v, vn); } }
}

__device__ __forceinline__ void flash(const Job& jb, LAS char* lds, unsigned tiles, unsigned W, bool use_sel) {
    int tid = threadIdx.x; asm volatile("" : "+v"(tid));
    const int wid = __builtin_amdgcn_readfirstlane(tid >> 6), lane = tid & 63, r32 = lane & 31, hi = lane >> 5;
    const int head = jb.nsa ? (wid & 3) : jb.head; const int qpos0w = jb.pos0 + 32 * (jb.nsa ? (wid >> 2) : wid); const int qpos = qpos0w + r32;
    LAS float* wsf = (LAS float*)(lds + OFF_WS) + wid * 64;
    bf16x8 qr[8]; load_q(qr, jb, qpos, head, hi);
    const unsigned rowsel = use_sel ? ((const LAS unsigned*)(lds + OFF_SEL))[qpos - jb.pos0] : 0xffffffffu;
    const int sr = tid >> 4, sch = tid & 15;
    const int vb00 = (int)(uintptr_t)(lds + OFF_V) + v_rd_base(lane);
    float m_reg = -1e30f, l_reg = 0.f; f32x16 o[4] = {};
    Stage st;
    unsigned rem = tiles; int j = __builtin_ctz(rem); rem &= rem - 1; int buf = 0;
    stage_load(st, jb, j * 64, sr, sch);
    __syncthreads();
    stage_write(st, lds, 0, sr, sch);
    __syncthreads();
    for (;;) {
        const bool has_next = rem != 0u; int jn = 0;
        if (has_next) { jn = __builtin_ctz(rem); rem &= rem - 1; stage_load(st, jb, jn * 64, sr, sch); }
        f32x16 p0, p1;
        qkt(p0, p1, lds + OFF_K + buf * SHM_K, r32, hi, qr);
        const int kb = j * 64;
        { const bool rowok = (rowsel >> j) & 1u; const unsigned We = rowok ? W : 0u;
          const bool need = (kb + 63 > qpos0w) || ((long)kb <= (long)qpos0w + 31 - (long)W) || use_sel;
          if (need) mask_tile(p0, p1, qpos - kb - 4 * hi, We); }
        float pmax = p0[0];
#pragma unroll
        for (int r = 1; r < 16; ++r) pmax = fmaxf(pmax, p0[r]);
#pragma unroll
        for (int r = 0; r < 16; ++r) pmax = fmaxf(pmax, p1[r]);
        pmax = half_swap_max(pmax);
        const float mn = fmaxf(m_reg, pmax); const float alpha = __builtin_amdgcn_exp2f((m_reg - mn) * C2); m_reg = mn;
        const float mnL = -mn * C2; float ps = 0.f;
#pragma unroll
        for (int r = 0; r < 16; ++r) { p0[r] = __builtin_amdgcn_exp2f(fmaf(p0[r], C2, mnL)); ps += p0[r]; }
#pragma unroll
        for (int r = 0; r < 16; ++r) { p1[r] = __builtin_amdgcn_exp2f(fmaf(p1[r], C2, mnL)); ps += p1[r]; }
        ps = half_swap_sum(ps); l_reg = l_reg * alpha + ps;
        if (__any(alpha < 1.f)) { if (hi == 0) wsf[32 + r32] = alpha; asm volatile("s_waitcnt lgkmcnt(0)" ::: "memory");
#pragma unroll
            for (int r = 0; r < 16; ++r) { const float a = wsf[32 + crow(r, hi)];
#pragma unroll
                for (int d = 0; d < 4; ++d) o[d][r] *= a; } }
        bf16x8 pa0, pa1, pa2, pa3; pack_p(p0, p1, pa0, pa1, pa2, pa3);
        pv_tile(o, vb00 + buf * SHM_V, pa0, pa1, pa2, pa3);
        if (!has_next) break;
        stage_write(st, lds, buf ^ 1, sr, sch);
        __syncthreads();
        buf ^= 1; j = jn;
    }
    store_o(o, l_reg, jb, wsf, qpos0w, head, r32, hi);
}

__device__ __forceinline__ unsigned cmp_select(const Job& jb, LAS char* lds) {
    int tid = threadIdx.x; asm volatile("" : "+v"(tid));
    const int wid = __builtin_amdgcn_readfirstlane(tid >> 6), lane = tid & 63, r32 = lane & 31, hi = lane >> 5;
    const int head = wid & 3; const int qpos0w = jb.pos0 + 32 * (wid >> 2); const int qpos = qpos0w + r32;
    LAS float* wsf = (LAS float*)(lds + OFF_WS) + wid * 64;
    bf16x8 qr[8]; load_q(qr, jb, qpos, head, hi);
    const int sr = tid >> 4, sch = tid & 15;
    const int vb00 = (int)(uintptr_t)(lds + OFF_V) + v_rd_base(lane);
    Stage s0, s1; stage_load(s0, jb, 0, sr, sch); stage_load(s1, jb, 64, sr, sch);
    __syncthreads();
    stage_write(s0, lds, 0, sr, sch); stage_write(s1, lds, 1, sr, sch);
    __syncthreads();
    f32x16 a0, a1, b0, b1;
    qkt(a0, a1, lds + OFF_K, r32, hi, qr); qkt(b0, b1, lds + OFF_K + SHM_K, r32, hi, qr);
    const int nmax = qpos >= 31 ? ((qpos - 31) >> 4) : -1;
    mask_tile(a0, a1, nmax - 4 * hi, 0x7fffffffu); mask_tile(b0, b1, nmax - 64 - 4 * hi, 0x7fffffffu);
    float pmax = -__builtin_inff();
#pragma unroll
    for (int r = 0; r < 16; ++r) pmax = fmaxf(fmaxf(pmax, a0[r]), fmaxf(a1[r], fmaxf(b0[r], b1[r])));
    pmax = half_swap_max(pmax); if (pmax < -1e37f) pmax = 0.f;
    const float mnL = -pmax * C2; float ps = 0.f;
#pragma unroll
    for (int r = 0; r < 16; ++r) { a0[r] = __builtin_amdgcn_exp2f(fmaf(a0[r], C2, mnL)); a1[r] = __builtin_amdgcn_exp2f(fmaf(a1[r], C2, mnL)); b0[r] = __builtin_amdgcn_exp2f(fmaf(b0[r], C2, mnL)); b1[r] = __builtin_amdgcn_exp2f(fmaf(b1[r], C2, mnL));
        ps += (a0[r] + a1[r]) + (b0[r] + b1[r]); }
    ps = half_swap_sum(ps); const float inv = ps > 0.f ? 1.f / ps : 0.f;
#pragma unroll
    for (int r = 0; r < 16; ++r) { a0[r] *= inv; a1[r] *= inv; b0[r] *= inv; b1[r] *= inv; }
    LAS float* imp = (LAS float*)(lds + OFF_IMP) + (wid * 32 + r32) * 32;
#define GRP(P, gq, i) do { const float s_ = (P[4 * gq] + P[4 * gq + 1]) + (P[4 * gq + 2] + P[4 * gq + 3]); const float pc = __shfl_xor(P[4 * gq + 3], 32); \
        imp[2 * (i) + hi] = s_ + (hi ? pc : pcp); pcp = pc; } while (0)
    { float pcp = 0.f;
      GRP(a0, 0, 0); GRP(a0, 1, 1); GRP(a0, 2, 2); GRP(a0, 3, 3); GRP(a1, 0, 4); GRP(a1, 1, 5); GRP(a1, 2, 6); GRP(a1, 3, 7);
      GRP(b0, 0, 8); GRP(b0, 1, 9); GRP(b0, 2, 10); GRP(b0, 3, 11); GRP(b1, 0, 12); GRP(b1, 1, 13); GRP(b1, 2, 14); GRP(b1, 3, 15); }
#undef GRP
    f32x16 o[4] = {};
    { bf16x8 pa0, pa1, pa2, pa3; pack_p(a0, a1, pa0, pa1, pa2, pa3); pv_tile(o, vb00, pa0, pa1, pa2, pa3);
      pack_p(b0, b1, pa0, pa1, pa2, pa3); pv_tile(o, vb00 + SHM_V, pa0, pa1, pa2, pa3); }
    store_o(o, 1.f, jb, wsf, qpos0w, head, r32, hi);
    __syncthreads();
    unsigned uni = 0u;
    if (tid < 64) { const int q = tid; const int cur = jb.pos0 >> 6;
        LAS float* sc = (LAS float*)(lds + OFF_IMP) + 256 * 32 + q * 33;
        const LAS float* ib = (const LAS float*)(lds + OFF_IMP) + (((q >> 5) * 4) * 32 + (q & 31)) * 32;
        for (int k = 0; k < 32; ++k) { const float v = ib[k] + ib[32 * 32 + k] + ib[2 * 32 * 32 + k] + ib[3 * 32 * 32 + k];
            const bool forced = (k == 0) || (k <= cur && k > cur - 2); sc[k] = forced ? 1e4f : (k <= cur ? v : -1.f); }
        unsigned m = 0u;
        for (int it = 0; it < 8; ++it) { float best = -__builtin_inff(); int bi = 0; for (int k = 0; k < 32; ++k) { const float v = sc[k]; if (v > best) { best = v; bi = k; } } m |= 1u << bi; sc[bi] = -__builtin_inff(); }
        const unsigned valid = cur >= 31 ? 0xffffffffu : ((1u << (cur + 1)) - 1u); m &= valid;
        ((LAS unsigned*)(lds + OFF_SEL))[q] = m;
        unsigned u = m; for (int ofs = 32; ofs > 0; ofs >>= 1) u |= (unsigned)__shfl_xor((int)u, ofs);
        if (q == 0) ((LAS unsigned*)(lds + OFF_SEL))[64] = u; }
    __syncthreads();
    uni = ((const LAS unsigned*)(lds + OFF_SEL))[64];
    return (unsigned)__builtin_amdgcn_readfirstlane((int)uni);
}
}

struct AClass { int type, idx, cost, n; };
struct AOrder { AClass c[72]; };
constexpr AOrder make_aorder() {
    AOrder o{}; int n = 0;
    for (int q = 0; q < 8; ++q) o.c[n++] = AClass{0, q, 4 * (q + 1), 32};
    for (int c = 0; c < 32; ++c) o.c[n++] = AClass{1, c, (c + 1 < 9 ? c + 1 : 9), 8};
    for (int c = 0; c < 32; ++c) o.c[n++] = AClass{2, c, 4 + c, 8};
    for (int i = 1; i < 72; ++i) { AClass k = o.c[i]; int j = i - 1; while (j >= 0 && o.c[j].cost < k.cost) { o.c[j + 1] = o.c[j]; --j; } o.c[j + 1] = k; }
    return o;
}
__device__ const AOrder g_aorder = make_aorder();
constexpr int N_AITEMS = 8 * 32 + 32 * 8 + 32 * 8;

constexpr int LDS_MISC = 131072;
constexpr int LM_BAR = LDS_MISC, LM_Q = LDS_MISC + 16, LM_TILES = LDS_MISC + 320  , LM_CNT = LDS_MISC + 512  , LM_DESC = LDS_MISC + 768;
constexpr int LM_UREC = LDS_MISC + 768 + DEPTH_ * 16 * 160;
constexpr int LDS_BYTES = LM_UREC + 16 * 64;
static_assert(sizeof(g8::GDesc) <= 160, "desc size");

__device__ __forceinline__ void moe_prefix(const Params& P, int l, LAS unsigned char* lds) {
    OPQ_IDS
    __syncthreads();
    if (TID_ == 0) { unsigned* cnt = (unsigned*)(P.ws + WS.ctl) + CW_CNT + l * 2048; LAS int* tiles = (LAS int*)(lds + LM_TILES); LAS int* lc = (LAS int*)(lds + LM_CNT); int acc = 0;
        for (int e = 0; e < 32; ++e) { const int c = (int)__hip_atomic_load(cnt + e * 64, __ATOMIC_RELAXED, __HIP_MEMORY_SCOPE_AGENT); lc[e] = c; tiles[e] = acc; acc += (c + 255) >> 8; } tiles[32] = acc; }
    __syncthreads();
}

__device__ __forceinline__ void build_descs(const Params& P, int l, LAS unsigned char* lds) {
    OPQ_IDS
    __syncthreads();
    if (TID_ == 0) {
        unsigned char* ws = P.ws; asm volatile("" : "+s"(ws));
        LAS g8::GDesc* tab = (LAS g8::GDesc*)(lds + LM_DESC + l * 16 * 160); asm volatile("" : "+v"(tab));
        auto mk = [&](int i, const void* A, long long ags, int lda, const void* B, long long bgs, int ldb, int K, int nM, int nN, int nG, int epi, int perm, void* C, long long cgs, int ldc, int coff) {
            LAS g8::GDesc& d = tab[i]; d.A = (const bf16_t*)A; d.B = (const bf16_t*)B; d.a_gs = ags; d.b_gs = bgs; d.lda = lda; d.ldb = ldb; d.K = K; d.nM = nM; d.nN = nN; d.nG = nG; d.epi = epi; d.perm = perm;
            d.C = C; d.c_gs = cgs; d.ldc = ldc; d.coff = coff; d.nvalid = 1 << 30; d.moe = 0; d.v0 = nullptr; d.v1 = nullptr; d.aux = nullptr; d.aux_gs = 0; d.aux_ld = 0; d.X = nullptr; };
        mk(0, ws + WS.h, 0, DM, ws + WS.win, 0, DM, DM, 64, 12, 1, g8::E_BF16, 1, ws + WS.cols, 0, NINP, 0);
        mk(1, ws + WS.cqn, 0, 512, ws + WS.wuq, 0, 512, 512, 64, 2, 1, g8::E_BF16, 1, ws + WS.mq, 0, 512, 0);
        mk(2, ws + WS.ckvn, 0, 256, ws + WS.wukv, 0, 256, 256, 64, 4, 1, g8::E_BF16, 1, ws + WS.mkv, 0, 1024, 0);
        mk(3, ws + WS.kcc, 512, 2048, ws + WS.wcmp1, 512, 2048, 512, 4, 1, 4, g8::E_F32, 0, ws + WS.zk, (long long)1024 * 256, 256, 0);
        mk(4, ws + WS.vcc, 512, 2048, (bf16_t*)(ws + WS.wcmp1) + (size_t)256 * 2048, 512, 2048, 512, 4, 1, 4, g8::E_F32, 0, ws + WS.zv, (long long)1024 * 256, 256, 0);
        mk(5, ws + WS.pd, 0, 512, ws + WS.wpool, 0, 512, 512, 64, 2, 1, g8::E_POOL, 1, ws + WS.ycat, 0, DM, 1024);
        tab[5].v0 = in_ptr(11) + (size_t)l * 512; tab[5].v1 = in_ptr(12) + (size_t)l * 512;
        mk(6, ws + WS.ud, (long long)S5ROWS * 512, 512, ws + WS.s5t, 512 * 512, 512, 512, 2, 2, 32, g8::E_BF16, 1, ws + WS.yintra, (long long)S5ROWS * 512, 512, 0);
        mk(7, ws + WS.ud, (long long)S5ROWS * 512, 512, ws + WS.s5w, 256 * 512, 512, 512, 2, 1, 32, g8::E_F32, 0, ws + WS.xend, (long long)S5ROWS * 128, 128, 0); tab[7].nvalid = 128;
        mk(8, ws + WS.xprev, (long long)S5ROWS * 256, 256, ws + WS.s5v, 512 * 256, 256, 256, 2, 2, 32, g8::E_S5OUT, 1, ws + WS.yg, 0, 512, 0);
        tab[8].aux = (const bf16_t*)(ws + WS.yintra); tab[8].aux_gs = (long long)S5ROWS * 512; tab[8].aux_ld = 512;
        mk(9, ws + WS.yg, 0, 512, ws + WS.wglu, 0, 512, 512, 64, 2, 1, g8::E_GLU, 1, ws + WS.ycat, 0, DM, 1536);
        tab[9].v0 = in_ptr(22) + (size_t)l * 512; tab[9].aux = (const bf16_t*)(ws + WS.yg); tab[9].aux_ld = 512;
        mk(10, ws + WS.ycat, 0, DM, ws + WS.wout, 0, DM, DM, 64, 8, 1, g8::E_RESID, 0, P.out, 0, DM, 0); tab[10].X = l == 0 ? in_ptr(0) : P.out;
        mk(11, ws + WS.h, 512, DM, ws + WS.wrt, 512, DM, 512, 64, 1, 4, g8::E_F32, 0, ws + WS.logits, (long long)T_ * 64, 64, 0); tab[11].nvalid = 64;
        mk(12, ws + WS_XG, 0, DM, ws + WS.wgu, (long long)1024 * DM, DM, DM, 0, 4, 32, g8::E_SWIGLU, 0, ws + WS.hmid, 0, MOE_H, 0); tab[12].moe = 1;
        mk(13, ws + WS.hmid, 0, MOE_H, ws + WS.wdn, (long long)DM * MOE_H, MOE_H, MOE_H, 0, 8, 32, g8::E_DOWN, 1, ws + WS.yd, 0, DM, 0); tab[13].moe = 2;
    }
    __syncthreads();
}

__device__ __forceinline__ void run_gemms(const Params& P, LAS unsigned char* lds, int l, int d_lo, int d_hi) {
    LAS unsigned char* lm = lds; asm volatile("" : "+v"(lm));
    g8::UnitSrc S; S.tab = (const LAS g8::GDesc*)(lm + LM_DESC + l * 16 * 160); S.d_lo = d_lo; S.d_hi = d_hi; S.G = gridDim.x; S.c = blockIdx.x; S.moe_tiles = (const LAS int*)(lm + LM_TILES); S.rec = (LAS g8::URec*)(lm + LM_UREC);
    unsigned char* ws = P.ws; asm volatile("" : "+s"(ws));
    g8::MoeCtx mc; mc.cnt = (const LAS int*)(lm + LM_CNT); mc.mlist = (const int*)(ws + WS.mlist); mc.mwt = (const float*)(ws + WS.mwt);
    __syncthreads();
    S.build(mc);
    __syncthreads();
    g8::gemm_run(lds, S, mc);
    __syncthreads();
}

__device__ __forceinline__ void phase_attention(const Params& P, int l, LAS unsigned char* ldsu, LAS unsigned char* ldsv, int rep) {
    OPQ_IDS
    unsigned char* ws = P.ws; asm volatile("" : "+s"(ws)); LAS char* lds = (LAS char*)ldsu;
    unsigned* qhead = (unsigned*)(ws + WS.ctl) + CW_QUEUE + l * 64 + rep * 16;
    const bf16_t* cols = (const bf16_t*)(ws + WS.cols);
    for (;;) {
        __syncthreads();
        if (TID_ == 0) *(LAS unsigned*)(ldsv + LM_Q) = atomicAdd(qhead, 1u);
        __syncthreads();
        const int item = __builtin_amdgcn_readfirstlane((int)*(const LAS unsigned*)(ldsv + LM_Q));
        if (item >= N_AITEMS) break;
        int rem = item, ci = 0; while (rem >= g_aorder.c[ci].n) { rem -= g_aorder.c[ci].n; ++ci; }
        const int type = g_aorder.c[ci].type, idx = g_aorder.c[ci].idx;
        at::Job jb{}; jb.rope = (const float*)(ws + WS.rope);
        unsigned tiles = 1u, W = 0x7fffffffu; bool use_sel = false;
        if (type == 0) { const int b = rem >> 2, h = rem & 3; const size_t t0 = (size_t)b * S_;
            jb.Q = (const bf16_t*)(ws + WS.mq) + t0 * 512; jb.ldq = 512;
            jb.K = (const bf16_t*)(ws + WS.mkv) + t0 * 1024 + h * 128; jb.ldk = 1024; jb.Kalt = (const bf16_t*)(ws + WS.krope) + t0 * 32; jb.ldkalt = 32;
            jb.V = (const bf16_t*)(ws + WS.mkv) + t0 * 1024 + 512 + h * 128; jb.ldv = 1024;
            jb.O = (bf16_t*)(ws + WS.ycat) + t0 * DM; jb.ldo = DM; jb.gate = nullptr; jb.rope_d0 = 6; jb.nsa = 0; jb.head = h; jb.pos0 = idx * 256;
            const int nt = 4 * (idx + 1); tiles = nt >= 32 ? 0xffffffffu : ((1u << nt) - 1u);
        } else { const int b = rem; const size_t t0 = (size_t)b * S_; const int c = idx;
            jb.Q = cols + t0 * NINP + C_Q; jb.ldq = NINP; jb.Kalt = nullptr; jb.ldkalt = 0; jb.rope_d0 = 0; jb.nsa = 1; jb.head = 0; jb.pos0 = c * 64;
            jb.gate = cols + t0 * NINP + C_GL; jb.ldg = NINP; jb.ldo = 512;
            if (type == 1) {
                jb.K = cols + t0 * NINP + C_KW; jb.ldk = NINP; jb.V = cols + t0 * NINP + C_VW; jb.ldv = NINP; jb.O = (bf16_t*)(ws + WS.ow) + t0 * 512; jb.gofs = 2;
                const int jlo = c - 8 > 0 ? c - 8 : 0; tiles = (c >= 31 ? 0xffffffffu : ((1u << (c + 1)) - 1u)) & ~((1u << jlo) - 1u); W = 512u;
            } else {
                jb.K = (const bf16_t*)(ws + WS.kcmp) + (size_t)b * 128 * 128; jb.ldk = 128; jb.V = (const bf16_t*)(ws + WS.vcmp) + (size_t)b * 128 * 128; jb.ldv = 128;
                jb.O = (bf16_t*)(ws + WS.oc) + t0 * 512; jb.gofs = 0;
                tiles = at::cmp_select(jb, lds); use_sel = true;
                jb.K = cols + t0 * NINP + C_KS; jb.ldk = NINP; jb.V = cols + t0 * NINP + C_VS; jb.ldv = NINP; jb.O = (bf16_t*)(ws + WS.os) + t0 * 512; jb.gofs = 1;
            }
        }
        at::flash(jb, lds, tiles, W, use_sel);
    }
}

constexpr int PH_PER_LAYER = 16, PH_FINAL_BIT = 16;
template <unsigned MASK>
__global__ void __launch_bounds__(512, 2) fwd_kernel(Params P) {
    LAS unsigned char* lds = (LAS unsigned char*)smem;
    if (threadIdx.x < 4) ((LAS unsigned*)(lds + LM_BAR))[threadIdx.x] = 0u;
    if (threadIdx.x == 0) { LAS unsigned* d = (LAS unsigned*)(lds + LM_INP_OFF); unsigned long long a;
        a = (unsigned long long)P.in[0]; d[0] = (unsigned)a; d[1] = (unsigned)(a >> 32);
        a = (unsigned long long)P.in[1]; d[2] = (unsigned)a; d[3] = (unsigned)(a >> 32);
        a = (unsigned long long)P.in[2]; d[4] = (unsigned)a; d[5] = (unsigned)(a >> 32);
        a = (unsigned long long)P.in[3]; d[6] = (unsigned)a; d[7] = (unsigned)(a >> 32);
        a = (unsigned long long)P.in[4]; d[8] = (unsigned)a; d[9] = (unsigned)(a >> 32);
        a = (unsigned long long)P.in[5]; d[10] = (unsigned)a; d[11] = (unsigned)(a >> 32);
        a = (unsigned long long)P.in[6]; d[12] = (unsigned)a; d[13] = (unsigned)(a >> 32);
        a = (unsigned long long)P.in[7]; d[14] = (unsigned)a; d[15] = (unsigned)(a >> 32);
        a = (unsigned long long)P.in[8]; d[16] = (unsigned)a; d[17] = (unsigned)(a >> 32);
        a = (unsigned long long)P.in[9]; d[18] = (unsigned)a; d[19] = (unsigned)(a >> 32);
        a = (unsigned long long)P.in[10]; d[20] = (unsigned)a; d[21] = (unsigned)(a >> 32);
        a = (unsigned long long)P.in[11]; d[22] = (unsigned)a; d[23] = (unsigned)(a >> 32);
        a = (unsigned long long)P.in[12]; d[24] = (unsigned)a; d[25] = (unsigned)(a >> 32);
        a = (unsigned long long)P.in[13]; d[26] = (unsigned)a; d[27] = (unsigned)(a >> 32);
        a = (unsigned long long)P.in[14]; d[28] = (unsigned)a; d[29] = (unsigned)(a >> 32);
        a = (unsigned long long)P.in[15]; d[30] = (unsigned)a; d[31] = (unsigned)(a >> 32);
        a = (unsigned long long)P.in[16]; d[32] = (unsigned)a; d[33] = (unsigned)(a >> 32);
        a = (unsigned long long)P.in[17]; d[34] = (unsigned)a; d[35] = (unsigned)(a >> 32);
        a = (unsigned long long)P.in[18]; d[36] = (unsigned)a; d[37] = (unsigned)(a >> 32);
        a = (unsigned long long)P.in[19]; d[38] = (unsigned)a; d[39] = (unsigned)(a >> 32);
        a = (unsigned long long)P.in[20]; d[40] = (unsigned)a; d[41] = (unsigned)(a >> 32);
        a = (unsigned long long)P.in[21]; d[42] = (unsigned)a; d[43] = (unsigned)(a >> 32);
        a = (unsigned long long)P.in[22]; d[44] = (unsigned)a; d[45] = (unsigned)(a >> 32);
        a = (unsigned long long)P.in[23]; d[46] = (unsigned)a; d[47] = (unsigned)(a >> 32);
        a = (unsigned long long)P.in[24]; d[48] = (unsigned)a; d[49] = (unsigned)(a >> 32);
        a = (unsigned long long)P.in[25]; d[50] = (unsigned)a; d[51] = (unsigned)(a >> 32);
        a = (unsigned long long)P.in[26]; d[52] = (unsigned)a; d[53] = (unsigned)(a >> 32);
        a = (unsigned long long)P.in[27]; d[54] = (unsigned)a; d[55] = (unsigned)(a >> 32);
        a = (unsigned long long)P.in[28]; d[56] = (unsigned)a; d[57] = (unsigned)(a >> 32);
        a = (unsigned long long)P.in[29]; d[58] = (unsigned)a; d[59] = (unsigned)(a >> 32);
        a = (unsigned long long)P.in[30]; d[60] = (unsigned)a; d[61] = (unsigned)(a >> 32);
        a = (unsigned long long)P.in[31]; d[62] = (unsigned)a; d[63] = (unsigned)(a >> 32);
        a = (unsigned long long)P.in[32]; d[64] = (unsigned)a; d[65] = (unsigned)(a >> 32);
        a = (unsigned long long)P.in[33]; d[66] = (unsigned)a; d[67] = (unsigned)(a >> 32);
    }
    __syncthreads();
    XcdBarrier bar = xcd_barrier_post((unsigned*)(P.ws + WS.ctl) + CW_BAR, (volatile LAS unsigned*)(lds + LM_BAR));
    unsigned char* ws = P.ws; asm volatile("" : "+s"(ws));
    constexpr bool MULTI = (MASK & (MASK - 1)) != 0;
#define PHASE(p) if constexpr ((MASK >> (p)) & 1u)
#define SEAM() do { if constexpr (MULTI) xcd_barrier(bar); } while (0)
    if constexpr (MULTI) xcd_barrier_census(bar);
    for (int l = P.ph_lo; l < P.ph_hi; ++l) build_descs(P, l, lds);
    for (int l = P.ph_lo; l < P.ph_hi; ++l) {
        LAS unsigned char* ldsv = lds;
        PHASE(0) {
            if (l == 0) phase_rmsnorm(in_ptr(0), in_ptr(1), (bf16_t*)(ws + WS.h));
            else { moe_prefix(P, l - 1, ldsv); phase_combine(P, l - 1, (const LAS int*)(ldsv + LM_TILES), in_ptr(1) + (size_t)l * DM, false); }
            phase_convert(P, l, lds);
            phase_precompute(P, l, lds);
            SEAM();
            if constexpr (REP_MASK & 1u) { phase_convert(P, l, lds); phase_precompute(P, l, lds); SEAM(); } }
        PHASE(1) { run_gemms(P, lds, l, 0, 1); SEAM(); if constexpr ((REP_MASK >> 1) & 1u) { run_gemms(P, lds, l, 0, 1); SEAM(); } }
        PHASE(2) { phase_post_inproj(P, l); phase_s5_toeplitz(P); SEAM(); if constexpr ((REP_MASK >> 2) & 1u) { phase_post_inproj(P, l); phase_s5_toeplitz(P); SEAM(); } }
        PHASE(3) { run_gemms(P, lds, l, 1, 8); SEAM(); if constexpr ((REP_MASK >> 3) & 1u) { run_gemms(P, lds, l, 1, 8); SEAM(); } }
        PHASE(4) { phase_cmp_finish(P, l, (LAS float*)lds); phase_s5_scan(P, l); SEAM(); if constexpr ((REP_MASK >> 4) & 1u) { phase_cmp_finish(P, l, (LAS float*)lds); phase_s5_scan(P, l); SEAM(); } }
        PHASE(6) { run_gemms(P, lds, l, 8, 9); phase_attention(P, l, lds, ldsv, 0); SEAM(); if constexpr ((REP_MASK >> 6) & 1u) { phase_attention(P, l, lds, ldsv, 1); SEAM(); } }
        PHASE(7) { run_gemms(P, lds, l, 9, 10); SEAM(); if constexpr ((REP_MASK >> 7) & 1u) { run_gemms(P, lds, l, 9, 10); SEAM(); } }
        PHASE(8) { phase_mixnorm(P, l); SEAM(); if constexpr ((REP_MASK >> 8) & 1u) { phase_mixnorm(P, l); SEAM(); } }
        PHASE(9) { run_gemms(P, lds, l, 10, 11); SEAM(); if constexpr ((REP_MASK >> 9) & 1u) { run_gemms(P, lds, l, 10, 11); SEAM(); } }
        PHASE(10) { phase_rmsnorm(P.out, in_ptr(25) + (size_t)l * DM, (bf16_t*)(ws + WS.h)); SEAM(); if constexpr ((REP_MASK >> 10) & 1u) { phase_rmsnorm(P.out, in_ptr(25) + (size_t)l * DM, (bf16_t*)(ws + WS.h)); SEAM(); } }
        PHASE(11) { run_gemms(P, lds, l, 11, 12); SEAM(); if constexpr ((REP_MASK >> 11) & 1u) { run_gemms(P, lds, l, 11, 12); SEAM(); } }
        PHASE(12) { phase_route(P, l); SEAM(); if constexpr ((REP_MASK >> 12) & 1u) { phase_route(P, l); SEAM(); } }
        PHASE(13) { moe_prefix(P, l, ldsv); phase_moe_gather(P, (const LAS int*)(ldsv + LM_TILES), (const LAS int*)(ldsv + LM_CNT)); SEAM(); if constexpr ((REP_MASK >> 13) & 1u) { moe_prefix(P, l, ldsv); phase_moe_gather(P, (const LAS int*)(ldsv + LM_TILES), (const LAS int*)(ldsv + LM_CNT)); SEAM(); } }
        PHASE(14) { moe_prefix(P, l, ldsv); run_gemms(P, lds, l, 12, 13); SEAM(); if constexpr ((REP_MASK >> 14) & 1u) { moe_prefix(P, l, ldsv); run_gemms(P, lds, l, 12, 13); SEAM(); } }
        PHASE(15) { moe_prefix(P, l, ldsv); run_gemms(P, lds, l, 13, 14); SEAM(); if constexpr ((REP_MASK >> 15) & 1u) { moe_prefix(P, l, ldsv); run_gemms(P, lds, l, 13, 14); SEAM(); } }
    }
    PHASE(PH_FINAL_BIT) { if (P.ph_hi == DEPTH_) { LAS unsigned char* ldsv = lds; moe_prefix(P, DEPTH_ - 1, ldsv); phase_combine(P, DEPTH_ - 1, (const LAS int*)(ldsv + LM_TILES), in_ptr(33), true); } }
#undef PHASE
#undef SEAM
}

template <unsigned MASK> static void launch_mask(const Params& p, int grid, hipStream_t stream) {
    static bool attr = false;
    if (!attr) { (void)hipFuncSetAttribute((const void*)fwd_kernel<MASK>, hipFuncAttributeMaxDynamicSharedMemorySize, LDS_BYTES); attr = true; }
    hipLaunchKernelGGL(fwd_kernel<MASK>, dim3(grid), dim3(512), LDS_BYTES, stream, p);
}

extern "C" void kernel_launch(void* const* d_in, const int* in_sizes, int n_in, void* d_out, int out_size, void* d_ws, size_t ws_size, hipStream_t stream) {
    static int grid = 0;
    if (grid == 0) {
        if (n_in != 34 || out_size != T_ * DM || ws_size < WS.end) { fprintf(stderr, "kernel_launch: unexpected shapes (n_in %d out %d ws %zu need %zu)\n", n_in, out_size, ws_size, (size_t)WS.end); grid = -1; return; }
        int dev = 0, cus = 0;
        if (hipGetDevice(&dev) != hipSuccess || hipDeviceGetAttribute(&cus, hipDeviceAttributeMultiprocessorCount, dev) != hipSuccess) { grid = -1; return; }
        grid = cus;
    }
    if (grid < 0) return;
    (void)hipMemsetAsync((char*)d_ws + WS.ctl, 0, CTL_BYTES, stream);
    Params p; memset(&p, 0, sizeof(p));
    for (int i = 0; i < 34; ++i) p.in[i] = (const float*)d_in[i];
    p.out = (float*)d_out; p.ws = (unsigned char*)d_ws;
#if N_LAUNCH_SPLIT
    for (int l = 0; l < DEPTH_; ++l) { p.ph_lo = l; p.ph_hi = l + 1;
        launch_mask<1u << 0>(p, grid, stream); launch_mask<1u << 1>(p, grid, stream); launch_mask<1u << 2>(p, grid, stream); launch_mask<1u << 3>(p, grid, stream);
        launch_mask<1u << 4>(p, grid, stream); launch_mask<1u << 5>(p, grid, stream); launch_mask<1u << 6>(p, grid, stream); launch_mask<1u << 7>(p, grid, stream);
        launch_mask<1u << 8>(p, grid, stream); launch_mask<1u << 9>(p, grid, stream); launch_mask<1u << 10>(p, grid, stream); launch_mask<1u << 11>(p, grid, stream);
        launch_mask<1u << 12>(p, grid, stream); launch_mask<1u << 13>(p, grid, stream); launch_mask<1u << 14>(p, grid, stream); launch_mask<1u << 15>(p, grid, stream); }
    p.ph_lo = DEPTH_; p.ph_hi = DEPTH_; launch_mask<1u << 16>(p, grid, stream);
#else
    p.ph_lo = 0; p.ph_hi = DEPTH_; launch_mask<0x1ffffu>(p, grid, stream);
#endif
}
```
